# Optimizing an MI355X kernel written in HIP

```python
import math
import jax, jax.numpy as jnp
from jax import lax
import numpy as np

D_MODEL = 2048
BATCH = 4
SEQ = 2048
DEPTH = 4
DEC_BATCH = 128
DEC_SEQ = 8
PAST_LEN = 16384
PAGE_SIZE = 128

CHUNK = 128
N_HEADS_A = 8
HEAD_DIM_A = 128
W_A = N_HEADS_A * HEAD_DIM_A
N_GROUPS_B = 8
W_B = D_MODEL - W_A
CONV_W = 3
D_FF = 5632
N_MOD = 6
IN_COLS = 2 * W_A + 3 * W_B
EPS = 1e-6

kernel_name = "hymba_style_gmlp_shortconv_convffn_step"


def rmsnorm(x, g):
    xf = x.astype(jnp.float32)
    y = xf * lax.rsqrt(jnp.mean(xf * xf, axis=-1, keepdims=True) + EPS)
    return (y * g.astype(jnp.float32)).astype(x.dtype)


def causal_conv3(x, past, w, b=None):
    xp = jnp.concatenate([past.astype(x.dtype), x], axis=1)
    y = w[0] * xp[:, :-2] + w[1] * xp[:, 1:-1] + w[2] * xp[:, 2:]
    if b is not None:
        y = y + b
    return y, xp[:, -(CONV_W - 1):]


def chunk_spatial_gate(z, g_v, w_s, b_s):
    bsz, t_len, _ = z.shape
    u, v = z[..., :W_A], z[..., W_A:]
    v = rmsnorm(v, g_v)
    blk = CHUNK if t_len >= CHUNK else t_len
    n_c = -(-t_len // blk)
    t_pad = n_c * blk
    vp = jnp.pad(v, ((0, 0), (0, t_pad - t_len), (0, 0)))
    vp = vp.reshape(bsz, n_c, blk, N_HEADS_A, HEAD_DIM_A)
    mask = jnp.tril(jnp.ones((blk, blk), dtype=bool))
    w = jnp.where(mask[None], w_s[:, :blk, :blk], jnp.zeros((), w_s.dtype))
    mixed = jnp.einsum('hts,bnshd->bnthd', w, vp)
    mixed = mixed + jnp.transpose(b_s[:, :blk])[None, None, :, :, None]
    mixed = mixed.reshape(bsz, t_pad, W_A)[:, :t_len]
    start = ((t_len - 1) // CHUNK) * CHUNK
    return u * mixed, v[:, start:]


def layer(x, c, past_mix, past_ffn, w_ada, b_ada, g_pre_mix, g_post_mix, g_pre_ffn, g_post_ffn,
          w_in, g_v, w_spatial, b_spatial, w_conv_mix, g_out_a, g_out_b, w_out,
          w_up, w_conv_ffn, b_conv_ffn, w_down):
    mod = jax.nn.silu(c) @ w_ada + b_ada
    sh1, sc1, gt1, sh2, sc2, gt2 = jnp.split(mod[:, None, :], N_MOD, axis=-1)

    h = rmsnorm(x, g_pre_mix) * (1 + sc1) + sh1
    proj = h @ w_in
    z_a = proj[..., :2 * W_A]
    gate_b = proj[..., 2 * W_A:2 * W_A + W_B]
    gate_c = proj[..., 2 * W_A + W_B:2 * W_A + 2 * W_B]
    h_b = proj[..., 2 * W_A + 2 * W_B:]
    out_a, v_rows = chunk_spatial_gate(jax.nn.gelu(z_a), g_v, w_spatial, b_spatial)
    conv_out, new_mix = causal_conv3(gate_c * h_b, past_mix, w_conv_mix)
    out_b = gate_b * conv_out
    merged = jnp.concatenate([rmsnorm(out_a, g_out_a), rmsnorm(out_b, g_out_b)], axis=-1) @ w_out
    x = x + gt1 * rmsnorm(merged, g_post_mix)

    h = rmsnorm(x, g_pre_ffn) * (1 + sc2) + sh2
    up = h @ w_up
    up_c, new_ffn = causal_conv3(up, past_ffn, w_conv_ffn, b_conv_ffn)
    ff = (jax.nn.silu(up_c[..., :D_FF]) * up_c[..., D_FF:]) @ w_down
    x = x + gt2 * rmsnorm(ff, g_post_ffn)
    return x, new_mix, new_ffn, v_rows


def run_trunk(x, c, past_mix, past_ffn, w_ada, b_ada, g_pre_mix, g_post_mix, g_pre_ffn, g_post_ffn,
              w_in, g_v, w_spatial, b_spatial, w_conv_mix, g_out_a, g_out_b, w_out,
              w_up, w_conv_ffn, b_conv_ffn, w_down):
    mixes, ffns, vrows = [], [], []
    for l in range(DEPTH):
        x, nm, nf, vr = layer(x, c, past_mix[:, l], past_ffn[:, l], w_ada[l], b_ada[l],
                              g_pre_mix[l], g_post_mix[l], g_pre_ffn[l], g_post_ffn[l],
                              w_in[l], g_v[l], w_spatial[l], b_spatial[l], w_conv_mix[l],
                              g_out_a[l], g_out_b[l], w_out[l],
                              w_up[l], w_conv_ffn[l], b_conv_ffn[l], w_down[l])
        mixes.append(nm)
        ffns.append(nf)
        vrows.append(vr)
    return x, jnp.stack(mixes, axis=1), jnp.stack(ffns, axis=1), jnp.stack(vrows, axis=1)


def setup_inputs(seed: int = 0) -> dict:
    key = jax.random.key(seed)
    ks = jax.random.split(key, 26)
    f32 = jnp.float32
    nrm = lambda k, shape, s: jax.random.normal(k, shape, f32) * s
    gain = lambda k, shape: 1.0 + 0.05 * jax.random.normal(k, shape, f32)
    return {
        "x_prompt": nrm(ks[0], (BATCH, SEQ, D_MODEL), 1.0),
        "x_sample": nrm(ks[1], (DEC_BATCH, DEC_SEQ, D_MODEL), 1.0),
        "state_conv_mix": nrm(ks[2], (DEC_BATCH, DEPTH, CONV_W - 1, W_B), 1.0),
        "state_conv_ffn": nrm(ks[3], (DEC_BATCH, DEPTH, CONV_W - 1, 2 * D_FF), 1.0),
        "c_prompt": nrm(ks[4], (BATCH, D_MODEL), 1.0),
        "c_sample": nrm(ks[5], (DEC_BATCH, D_MODEL), 1.0),
        "w_ada": nrm(ks[6], (DEPTH, D_MODEL, N_MOD * D_MODEL), 0.5 * D_MODEL ** -0.5),
        "b_ada": nrm(ks[7], (DEPTH, N_MOD * D_MODEL), 0.02),
        "g_pre_mix": gain(ks[8], (DEPTH, D_MODEL)),
        "g_post_mix": gain(ks[9], (DEPTH, D_MODEL)),
        "g_pre_ffn": gain(ks[10], (DEPTH, D_MODEL)),
        "g_post_ffn": gain(ks[11], (DEPTH, D_MODEL)),
        "w_in": nrm(ks[12], (DEPTH, D_MODEL, IN_COLS), D_MODEL ** -0.5),
        "g_v": gain(ks[13], (DEPTH, W_A)),
        "w_spatial": nrm(ks[14], (DEPTH, N_HEADS_A, CHUNK, CHUNK), 0.5 * CHUNK ** -0.5),
        "b_spatial": 1.0 + nrm(ks[15], (DEPTH, N_HEADS_A, CHUNK), 0.02),
        "w_conv_mix": nrm(ks[16], (DEPTH, CONV_W, W_B), CONV_W ** -0.5),
        "g_out_a": gain(ks[17], (DEPTH, W_A)),
        "g_out_b": gain(ks[18], (DEPTH, W_B)),
        "w_out": nrm(ks[19], (DEPTH, W_A + W_B, D_MODEL), (W_A + W_B) ** -0.5),
        "w_up": nrm(ks[20], (DEPTH, D_MODEL, 2 * D_FF), D_MODEL ** -0.5),
        "w_conv_ffn": nrm(ks[21], (DEPTH, CONV_W, 2 * D_FF), CONV_W ** -0.5),
        "b_conv_ffn": nrm(ks[22], (DEPTH, 2 * D_FF), 0.02),
        "w_down": nrm(ks[23], (DEPTH, D_FF, D_MODEL), D_FF ** -0.5),
    }


def reference(x_prompt, x_sample, state_conv_mix, state_conv_ffn, c_prompt, c_sample,
              w_ada, b_ada, g_pre_mix, g_post_mix, g_pre_ffn, g_post_ffn,
              w_in, g_v, w_spatial, b_spatial, w_conv_mix, g_out_a, g_out_b, w_out,
              w_up, w_conv_ffn, b_conv_ffn, w_down):
    weights = (w_ada, b_ada, g_pre_mix, g_post_mix, g_pre_ffn, g_post_ffn,
               w_in, g_v, w_spatial, b_spatial, w_conv_mix, g_out_a, g_out_b, w_out,
               w_up, w_conv_ffn, b_conv_ffn, w_down)
    bp = x_prompt.shape[0]
    zero_mix = jnp.zeros((bp, DEPTH, CONV_W - 1, W_B), x_prompt.dtype)
    zero_ffn = jnp.zeros((bp, DEPTH, CONV_W - 1, 2 * D_FF), x_prompt.dtype)
    y_prompt, mix_p, ffn_p, vrows_p = run_trunk(x_prompt, c_prompt, zero_mix, zero_ffn, *weights)
    y_sample, mix_s, ffn_s, vrows_s = run_trunk(x_sample, c_sample, state_conv_mix, state_conv_ffn, *weights)
    return (y_prompt, y_sample, mix_p, mix_s, ffn_p, ffn_s, vrows_p, vrows_s)
```

```cpp
#include <hip/hip_runtime.h>
#include <cstdio>
#include <cstdint>
#ifndef MK_PER_PHASE
#define MK_PER_PHASE 0
#endif
#ifdef NO_MA
#define MA(...)
#else
#define MA(...) __VA_ARGS__
#endif
#ifdef NO_MB
#define MB(...)
#else
#define MB(...) __VA_ARGS__
#endif
namespace pg8 {
#define PG8_LAS __attribute__((address_space(3)))
typedef unsigned short bf16_t;
typedef short bf16x8 __attribute__((ext_vector_type(8)));
typedef float f32x4 __attribute__((ext_vector_type(4)));
typedef unsigned u32x4 __attribute__((ext_vector_type(4)));
constexpr int BM = 256, BK = 64, HALF = 128, HTB = HALF * BK * 2  , STAGE_BYTES = 8 * HTB, NXCD = 8, WGM = 8;

__host__ __device__ __forceinline__ int lds_byte(int r, int c) { const int st = (r >> 4) * 2 + (c >> 5), rr = r & 15, cc = c & 31, ob = rr * 64 + cc * 2; return st * 1024 + (ob ^ (((ob >> 9) & 1) << 5)); }
__host__ __device__ __forceinline__ void stage_rc(int b, int& R, int& C) { const int st = b / 1024, sb = b % 1024, swz = sb ^ (((sb >> 9) & 1) << 5); R = (st >> 1) * 16 + swz / 64; C = (st & 1) * 32 + (swz % 64) / 2; }
__host__ __device__ __forceinline__ int perm32(int rho) { const int n = rho >> 4, i = rho & 15; return 8 * (i >> 2) + 4 * n + (i & 3); }

struct Unit { int pm, pn, ks; };
struct Gemm { const bf16_t* A; const bf16_t* Bt; int M, N, K; };

struct StaticOrder {
    int nM, nN, nwg, G, c, KT;
    __host__ __device__ void init(int M, int N, int K, int G_, int c_) { nM = M / BM; nN = N / BM; nwg = nM * nN; G = G_; c = c_; KT = K / BK; }
    __host__ __device__ bool next(int i, Unit& u) const {
        const long L = (long)i * G + c; if (L >= nwg) return false;
        int wgid = (int)L; { const int q = nwg / NXCD, r = nwg % NXCD, xcd = wgid % NXCD, off = wgid / NXCD; wgid = (xcd < r ? xcd * (q + 1) : r * (q + 1) + (xcd - r) * q) + off; }
        const int nig = WGM * nN, gid = wgid / nig, fm = gid * WGM, gsz = (nM - fm) < WGM ? (nM - fm) : WGM;
        u.pm = fm + ((wgid % nig) % gsz); u.pn = (wgid % nig) / gsz; u.ks = -1; return true;
    }
    __device__ __forceinline__ int k0(const Unit&) const { return 0; }
    __device__ __forceinline__ int nt(const Unit&) const { return KT; }
    __device__ __forceinline__ void a_ready(const Unit&) const {}
    __device__ __forceinline__ void done(const Unit&) const {}
};
struct SplitOrder {
    int G, c, KB;
    __host__ __device__ void init(int K, int G_, int c_) { G = G_; c = c_; KB = K / 128; }
    __host__ __device__ bool next(int i, Unit& u) const {
        const int L = i * G + c; if (L >= 512) return false;
        if (L < 256) { const int x = L & 7, j = L >> 3; u.pm = 4 * x + (j >> 3); u.pn = j & 7; u.ks = -1; }
        else { const int Ls = L - 256, j = Ls >> 3; u.pm = 32 + (j >> 3); u.pn = j & 7; u.ks = Ls & 7; }
        return true;
    }
    __device__ __forceinline__ int k0(const Unit& u) const { const int base = KB >> 3, rem = KB & 7; return u.ks < 0 ? 0 : 128 * (u.ks * base + (u.ks < rem ? u.ks : rem)); }
    __device__ __forceinline__ int nt(const Unit& u) const { const int base = KB >> 3, rem = KB & 7; return u.ks < 0 ? 2 * KB : 2 * (base + (u.ks < rem ? 1 : 0)); }
    __device__ __forceinline__ void a_ready(const Unit&) const {}
    __device__ __forceinline__ void done(const Unit&) const {}
};

__device__ __forceinline__ unsigned cvt_pk_bf16(float lo, float hi) { unsigned r; asm volatile("v_cvt_pk_bf16_f32 %0, %1, %2" : "=v"(r) : "v"(lo), "v"(hi)); return r; }
typedef float f32x2 __attribute__((ext_vector_type(2)));
__device__ __forceinline__ float gelu_tanh(float x) {
    const float z = x * (1.5957691216f + 0.0713548163f * x * x);
    const float e = __builtin_amdgcn_exp2f(-1.4426950409f * z);
    return x * __builtin_amdgcn_rcpf(1.0f + e);
}
struct EpiBf16G {
    static constexpr bool PERM = true, AFTER_DRAIN = false;
    bf16_t* O; int ldc; int ngelu;
    __device__ __forceinline__ void operator()(const f32x4 (&acc)[2][2][4][2], const Unit& u, int wr, int wc, int fr, int fq) const {
        const int row0 = u.pm * BM + wr * 64 + fr; const int col0 = u.pn * BM + wc * 32 + 8 * fq;
        const bool act = u.pn < ngelu;
#pragma unroll
        for (int ai = 0; ai < 2; ++ai)
#pragma unroll
            for (int m = 0; m < 4; ++m) { bf16_t* rowp = O + (size_t)(row0 + ai * HALF + m * 16) * ldc + col0;
#pragma unroll
                for (int bj = 0; bj < 2; ++bj) { f32x4 v0 = acc[ai][bj][m][0], v1 = acc[ai][bj][m][1];
                    if (act) {
#pragma unroll
                        for (int j = 0; j < 4; ++j) { v0[j] = gelu_tanh(v0[j]); v1[j] = gelu_tanh(v1[j]); } }
                    u32x4 w; w.x = cvt_pk_bf16(v0[0], v0[1]); w.y = cvt_pk_bf16(v0[2], v0[3]); w.z = cvt_pk_bf16(v1[0], v1[1]); w.w = cvt_pk_bf16(v1[2], v1[3]);
                    *(u32x4*)(rowp + bj * HALF) = w; } }
    }
};
struct EpiF32 {
    static constexpr bool PERM = false, AFTER_DRAIN = false;
    float* C; int ldc; const float* bias; float* Cpart;
    __device__ __forceinline__ void operator()(const f32x4 (&acc)[2][2][4][2], const Unit& u, int wr, int wc, int fr, int fq) const {
        const int row0 = u.pm * BM + wr * 64 + fr, col0 = u.pn * BM + wc * 32 + 4 * fq;
        float* Cb = u.ks < 0 ? C : Cpart + (ptrdiff_t)(u.ks * 1024 - 32 * BM) * ldc;
        f32x4 bv[2][2];
#pragma unroll
        for (int bj = 0; bj < 2; ++bj)
#pragma unroll
            for (int n = 0; n < 2; ++n) bv[bj][n] = bias ? *(const f32x4*)(bias + col0 + bj * HALF + n * 16) : (f32x4){0.f, 0.f, 0.f, 0.f};
#pragma unroll
        for (int ai = 0; ai < 2; ++ai)
#pragma unroll
            for (int m = 0; m < 4; ++m) { float* rowp = Cb + (size_t)(row0 + ai * HALF + m * 16) * ldc + col0;
#pragma unroll
                for (int bj = 0; bj < 2; ++bj)
#pragma unroll
                    for (int n = 0; n < 2; ++n) *(f32x4*)(rowp + bj * HALF + n * 16) = acc[ai][bj][m][n] + bv[bj][n]; }
    }
};
template <class Epi, class Sched, bool ALIGN_EPI = false, bool SP2 = false>
__device__ __forceinline__ void gemm_phase(PG8_LAS unsigned char* lds, const Gemm g, const Sched& S, const Epi& E) {
    int tid_ = threadIdx.x; asm volatile("" : "+v"(tid_));
    const int tid = tid_, wid = __builtin_amdgcn_readfirstlane(tid >> 6), lane = tid & 63, wr = wid >> 2, wc = wid & 3, fr = lane & 15, fq = lane >> 4;
    const int K = g.K;
    unsigned voffA[2], voffB[2];
#pragma unroll
    for (int i = 0; i < 2; ++i) { int R, C; stage_rc(tid * 16 + i * 8192, R, C); const int Rb = Epi::PERM ? ((R & ~31) + perm32(R & 31)) : R;
        voffA[i] = (unsigned)(R * K + C) * 2u; voffB[i] = (unsigned)(Rb * K + C) * 2u; }
    const size_t kstep = (size_t)(BK * 2);
    const size_t hstep = (size_t)HALF * K * 2;
    const size_t tstep = 2 * hstep;
    const unsigned ldsw = (unsigned)wid * 1024u;
    const int aoff = lds_byte(wr * 64 + fr, fq * 8), boff = lds_byte(wc * 32 + fr, fq * 8);
#define PG8_SA(b, h) (((b) * 2 + (h)) * HTB)
#define PG8_SB(b, h) ((4 + (b) * 2 + (h)) * HTB)
#define PG8_STAGE(bufoff, gbase, voff) do { _Pragma("unroll") for (int _i = 0; _i < 2; ++_i) \
        __builtin_amdgcn_global_load_lds((const unsigned*)((const char*)(gbase) + (voff)[_i]), (PG8_LAS unsigned*)(lds + (bufoff) + ldsw + _i * 8192), 16, 0, 0); } while (0)
#define PG8_LDA(dst, b, h) do { _Pragma("unroll") for (int m = 0; m < 4; ++m) _Pragma("unroll") for (int k = 0; k < 2; ++k) dst[m][k] = *(const PG8_LAS bf16x8*)(lds + PG8_SA(b, h) + aoff + m * 2048 + k * 1024); } while (0)
#define PG8_LDB(dst, b, h) do { _Pragma("unroll") for (int n = 0; n < 2; ++n) _Pragma("unroll") for (int k = 0; k < 2; ++k) dst[n][k] = *(const PG8_LAS bf16x8*)(lds + PG8_SB(b, h) + boff + n * 2048 + k * 1024); } while (0)
#define PG8_MMA(ai, bj, At, Bt) do { __builtin_amdgcn_s_setprio(1); _Pragma("unroll") for (int m = 0; m < 4; ++m) _Pragma("unroll") for (int n = 0; n < 2; ++n) _Pragma("unroll") for (int k = 0; k < 2; ++k) \
        acc[ai][bj][m][n] = __builtin_amdgcn_mfma_f32_16x16x32_bf16(Bt[n][k], At[m][k], acc[ai][bj][m][n], 0, 0, 0); __builtin_amdgcn_s_setprio(0); } while (0)
#define PG8_WAIT_V(n) asm volatile("s_waitcnt vmcnt(" #n ")" ::: "memory")
#define PG8_WAIT_L(n) asm volatile("s_waitcnt lgkmcnt(" #n ")" ::: "memory")
#define PG8_BAR __builtin_amdgcn_s_barrier()
#define PG8_SCHED __builtin_amdgcn_sched_barrier(0)
    Unit cur, nxt; int ui = 0;
    if (!S.next(0, cur)) return;
    f32x4 acc[2][2][4][2];
#pragma unroll
    for (int a = 0; a < 2; ++a)
#pragma unroll
        for (int b = 0; b < 2; ++b)
#pragma unroll
            for (int m = 0; m < 4; ++m)
#pragma unroll
                for (int n = 0; n < 2; ++n) acc[a][b][m][n] = (f32x4){0.f, 0.f, 0.f, 0.f};
    bf16x8 At[4][2], B0[2][2], B1[2][2];
    const char* cA = (const char*)g.A + (size_t)cur.pm * tstep + (size_t)S.k0(cur) * 2; const char* cB = (const char*)g.Bt + (size_t)cur.pn * tstep + (size_t)S.k0(cur) * 2;
    S.a_ready(cur);
    if constexpr (SP2) {
        PG8_STAGE(PG8_SB(0, 0), cB, voffB); PG8_STAGE(PG8_SB(0, 1), cB + hstep, voffB); PG8_STAGE(PG8_SA(0, 0), cA, voffA); PG8_STAGE(PG8_SA(0, 1), cA + hstep, voffA);
        if (wr == 1) PG8_BAR;
        PG8_WAIT_V(2); PG8_BAR;
        PG8_STAGE(PG8_SB(1, 0), cB + kstep, voffB); PG8_STAGE(PG8_SA(1, 0), cA + kstep, voffA); PG8_STAGE(PG8_SB(1, 1), cB + hstep + kstep, voffB);
        PG8_WAIT_V(6); PG8_BAR;
    } else {
        PG8_STAGE(PG8_SB(0, 0), cB, voffB); PG8_STAGE(PG8_SA(0, 0), cA, voffA); PG8_STAGE(PG8_SB(0, 1), cB + hstep, voffB); PG8_STAGE(PG8_SA(0, 1), cA + hstep, voffA);
        if (wr == 1) PG8_BAR;
        PG8_WAIT_V(4); PG8_BAR;
        PG8_STAGE(PG8_SB(1, 0), cB + kstep, voffB); PG8_STAGE(PG8_SA(1, 0), cA + kstep, voffA); PG8_STAGE(PG8_SB(1, 1), cB + hstep + kstep, voffB);
        PG8_WAIT_V(6); PG8_BAR;
    }
    for (;;) {
        const bool has_next = S.next(ui + 1, nxt);
        const char* nA = has_next ? (const char*)g.A + (size_t)nxt.pm * tstep + (size_t)S.k0(nxt) * 2 : cA; const char* nB = has_next ? (const char*)g.Bt + (size_t)nxt.pn * tstep + (size_t)S.k0(nxt) * 2 : cB;
        const int nt = S.nt(cur);
        for (int t = 0; t < nt; t += 2) {
            const bool last = (t == nt - 2);
            const char* a1 = cA + (size_t)(t + 1) * kstep;
            const char* a2 = last ? nA : cA + (size_t)(t + 2) * kstep; const char* b2 = last ? nB : cB + (size_t)(t + 2) * kstep;
            const char* a3 = a2 + kstep; const char* b3 = b2 + kstep;
            if (last && has_next) S.a_ready(nxt);
            if constexpr (SP2) {
            PG8_LDB(B0, 0, 0); PG8_LDB(B1, 0, 1); PG8_SCHED; PG8_LDA(At, 0, 0); PG8_STAGE(PG8_SA(1, 1), a1 + hstep, voffA);
            PG8_WAIT_V(8); PG8_WAIT_L(0); PG8_BAR; PG8_MMA(0, 0, At, B0); PG8_MMA(0, 1, At, B1); PG8_BAR; PG8_SCHED;
            PG8_LDA(At, 0, 1); PG8_STAGE(PG8_SB(0, 0), b2, voffB); PG8_STAGE(PG8_SB(0, 1), b2 + hstep, voffB); PG8_STAGE(PG8_SA(0, 0), a2, voffA);
            PG8_WAIT_V(8); PG8_WAIT_L(0); PG8_BAR; PG8_MMA(1, 0, At, B0); PG8_MMA(1, 1, At, B1); PG8_BAR; PG8_SCHED;
            PG8_LDB(B0, 1, 0); PG8_LDB(B1, 1, 1); PG8_SCHED; PG8_LDA(At, 1, 0); PG8_STAGE(PG8_SA(0, 1), a2 + hstep, voffA);
            PG8_WAIT_V(8); PG8_WAIT_L(0); PG8_BAR; PG8_MMA(0, 0, At, B0); PG8_MMA(0, 1, At, B1); PG8_BAR; PG8_SCHED;
            PG8_LDA(At, 1, 1); PG8_STAGE(PG8_SB(1, 0), b3, voffB); PG8_STAGE(PG8_SB(1, 1), b3 + hstep, voffB); PG8_STAGE(PG8_SA(1, 0), a3, voffA);
            PG8_WAIT_V(8); PG8_WAIT_L(0); PG8_BAR; PG8_MMA(1, 0, At, B0); PG8_MMA(1, 1, At, B1); PG8_BAR; PG8_SCHED;
            } else {
            PG8_LDB(B0, 0, 0); PG8_SCHED; PG8_LDA(At, 0, 0); PG8_STAGE(PG8_SA(1, 1), a1 + hstep, voffA);
            PG8_WAIT_L(8); PG8_BAR; PG8_WAIT_L(0); PG8_MMA(0, 0, At, B0); PG8_BAR; PG8_SCHED;
            PG8_LDB(B1, 0, 1); PG8_STAGE(PG8_SB(0, 0), b2, voffB);
            PG8_BAR; PG8_WAIT_L(0); PG8_MMA(0, 1, At, B1); PG8_BAR;
            PG8_LDA(At, 0, 1); PG8_STAGE(PG8_SA(0, 0), a2, voffA);
            PG8_BAR; PG8_WAIT_L(0); PG8_MMA(1, 0, At, B0); PG8_BAR; PG8_SCHED;
            PG8_STAGE(PG8_SB(0, 1), b2 + hstep, voffB);
            PG8_WAIT_V(6); PG8_BAR; PG8_MMA(1, 1, At, B1); PG8_BAR;
            PG8_LDB(B0, 1, 0); PG8_SCHED; PG8_LDA(At, 1, 0); PG8_STAGE(PG8_SA(0, 1), a2 + hstep, voffA);
            PG8_WAIT_L(8); PG8_BAR; PG8_WAIT_L(0); PG8_MMA(0, 0, At, B0); PG8_BAR; PG8_SCHED;
            PG8_LDB(B1, 1, 1); PG8_STAGE(PG8_SB(1, 0), b3, voffB);
            PG8_BAR; PG8_WAIT_L(0); PG8_MMA(0, 1, At, B1); PG8_BAR;
            PG8_LDA(At, 1, 1); PG8_STAGE(PG8_SA(1, 0), a3, voffA);
            PG8_BAR; PG8_WAIT_L(0); PG8_MMA(1, 0, At, B0); PG8_BAR; PG8_SCHED;
            PG8_STAGE(PG8_SB(1, 1), b3 + hstep, voffB);
            PG8_WAIT_V(6); PG8_BAR; PG8_MMA(1, 1, At, B1); PG8_BAR;
            }
        }
        if constexpr (ALIGN_EPI) { if (wr == 0) PG8_BAR; }
        if constexpr (!Epi::AFTER_DRAIN) { E(acc, cur, wr, wc, fr, fq); S.done(cur); }
        if (!has_next) break;
#pragma unroll
        for (int a = 0; a < 2; ++a)
#pragma unroll
            for (int b = 0; b < 2; ++b)
#pragma unroll
                for (int m = 0; m < 4; ++m)
#pragma unroll
                    for (int n = 0; n < 2; ++n) acc[a][b][m][n] = (f32x4){0.f, 0.f, 0.f, 0.f};
        cur = nxt; cA = nA; cB = nB; ++ui;
        if constexpr (ALIGN_EPI) { if (wr == 1) PG8_BAR; }
    }
    PG8_WAIT_V(0);
    if constexpr (!ALIGN_EPI) { if (wr == 0) PG8_BAR; }
    PG8_BAR;
    if constexpr (Epi::AFTER_DRAIN) { E.fused(acc, cur, wr, wc, fr, fq, lds, wid, lane); S.done(cur); }
#undef PG8_SA
#undef PG8_SB
#undef PG8_STAGE
#undef PG8_LDA
#undef PG8_LDB
#undef PG8_MMA
#undef PG8_WAIT_V
#undef PG8_WAIT_L
#undef PG8_BAR
#undef PG8_SCHED
}
}

constexpr int DM = 2048, NP = 4, TP = 2048, NL = 4, NS = 128, TS = 8;
constexpr int MP = NP * TP, MS = NS * TS, M = MP + MS;
constexpr int WA = 1024, WB = 1024, INC = 5120, FF = 5632, FF2 = 2 * FF, NMOD = 6 * DM, NMODALL = NL * NMOD;
constexpr int NSEQ = NP + NS;
constexpr float EPS = 1e-6f;
constexpr size_t O_YP = 0, O_YS = O_YP + (size_t)MP * DM, O_MIXP = O_YS + (size_t)MS * DM, O_MIXS = O_MIXP + (size_t)NP * NL * 2 * WB,
                 O_FFNP = O_MIXS + (size_t)NS * NL * 2 * WB, O_FFNS = O_FFNP + (size_t)NP * NL * 2 * FF2, O_CVP = O_FFNS + (size_t)NS * NL * 2 * FF2,
                 O_CVS = O_CVP + (size_t)NP * NL * 128 * WA, O_END = O_CVS + (size_t)NS * NL * TS * WA;
static_assert(O_END == 38141952, "output size");
constexpr size_t MiB = 1u << 20;
constexpr size_t WS_CTL = 0, CTL_ZERO_BYTES = 1 * MiB;
constexpr size_t WS_SC = 1 * MiB;
constexpr size_t WS_MOD = 2 * MiB;
constexpr size_t WS_WIN = 50 * MiB, WS_WOUT = 130 * MiB, WS_WUP = 162 * MiB, WS_WDN = 338 * MiB, WS_WADA = 426 * MiB;
constexpr size_t WS_X = 618 * MiB, WS_H = 690 * MiB, WS_PROJ = 726 * MiB, WS_MRG = 816 * MiB, WS_Y = 852 * MiB, WS_UP = 924 * MiB, WS_ACT = 1122 * MiB, WS_PART = 1221 * MiB, WS_END = 1285 * MiB;
static_assert(WS_MOD + (size_t)256 * NMODALL * 4 <= WS_WIN && WS_WIN + (size_t)NL * INC * DM * 2 <= WS_WOUT && WS_WOUT + (size_t)NL * DM * DM * 2 <= WS_WUP &&
              WS_WUP + (size_t)NL * FF2 * DM * 2 <= WS_WDN && WS_WDN + (size_t)NL * DM * FF * 2 <= WS_WADA && WS_WADA + (size_t)NMODALL * DM * 2 <= WS_X &&
              WS_X + (size_t)M * DM * 4 <= WS_H && WS_H + (size_t)M * DM * 2 <= WS_PROJ && WS_PROJ + (size_t)M * INC * 2 <= WS_MRG && WS_MRG + (size_t)M * DM * 2 <= WS_Y &&
              WS_Y + (size_t)M * DM * 4 <= WS_UP && WS_UP + (size_t)M * FF2 * 2 <= WS_ACT && WS_ACT + (size_t)M * FF * 2 <= WS_PART && WS_PART + (size_t)8 * MS * DM * 4 <= WS_END, "d_ws map");
constexpr int CW_BAR = 4096;
constexpr int RING_BYTES = 131072;
constexpr int MISC_OFF = RING_BYTES;
constexpr int TAB_OFF = RING_BYTES + 1024;
constexpr int LDS_BYTES = 147456;
constexpr int NWAVES = 8, NTHREADS = 512;
constexpr int NPHASES = 3 + 8 * NL;

#define GAS __attribute__((address_space(1)))
#define LAS __attribute__((address_space(3)))
typedef unsigned short bf16;
typedef unsigned v4u __attribute__((ext_vector_type(4)));
typedef unsigned v2u __attribute__((ext_vector_type(2)));
typedef float f32x4 __attribute__((ext_vector_type(4)));
typedef short bf16x8 __attribute__((ext_vector_type(8)));
typedef short s16x4 __attribute__((ext_vector_type(4)));
typedef GAS unsigned gu32;
#define RLX_AGENT __ATOMIC_RELAXED, __HIP_MEMORY_SCOPE_AGENT
#define LDS_WAIT() asm volatile("s_waitcnt lgkmcnt(0)" ::: "memory")
#define VM_WAIT() asm volatile("s_waitcnt vmcnt(0)" ::: "memory")
__device__ __forceinline__ unsigned pk2(float lo, float hi) { return pg8::cvt_pk_bf16(lo, hi); }
__device__ __forceinline__ float bflo(unsigned w) { return __builtin_bit_cast(float, w << 16); }
__device__ __forceinline__ float bfhi(unsigned w) { return __builtin_bit_cast(float, w & 0xffff0000u); }
__device__ __forceinline__ void unpack8(const v4u w, float (&f)[8]) { f[0] = bflo(w.x); f[1] = bfhi(w.x); f[2] = bflo(w.y); f[3] = bfhi(w.y); f[4] = bflo(w.z); f[5] = bfhi(w.z); f[6] = bflo(w.w); f[7] = bfhi(w.w); }
__device__ __forceinline__ v4u pack8(const float (&f)[8]) { v4u w; w.x = pk2(f[0], f[1]); w.y = pk2(f[2], f[3]); w.z = pk2(f[4], f[5]); w.w = pk2(f[6], f[7]); return w; }
__device__ __forceinline__ float wave_sum(float v) {
#pragma unroll
    for (int o = 1; o < 64; o <<= 1) v += __shfl_xor(v, o);
    return v;
}
__device__ __forceinline__ float silu_f(float x) { return x * __builtin_amdgcn_rcpf(1.0f + __builtin_amdgcn_exp2f(-1.4426950409f * x)); }

#define XB_TMO      128
#define XB_XCNT(j)  (256  + 64 * (j))
#define XB_XSUB(j)  (1280 + 64 * (j))
#define XB_XGEN(j)  (2304 + 64 * (j))
#define XB_TOP      3328
#define XB_TOPGEN   3392
#define XCD_BAR_WORDS 3456
#define XB_SPIN_CAP (1u << 18)

__device__ __forceinline__ unsigned xb_ld(unsigned* p)              { return __hip_atomic_load(p, __ATOMIC_RELAXED, __HIP_MEMORY_SCOPE_AGENT); }
__device__ __forceinline__ unsigned xb_add(unsigned* p, unsigned v) { return __hip_atomic_fetch_add(p, v, __ATOMIC_RELAXED, __HIP_MEMORY_SCOPE_AGENT); }
__device__ __forceinline__ unsigned xb_xcc_id() { return (unsigned)__builtin_amdgcn_s_getreg((3 << 11) | 20) & 0xFu; }
#define XB_SPIN(cond, bar) do { unsigned _sp = 0; while (cond) { __builtin_amdgcn_s_sleep(1); \
    if ((++_sp & 255u) == 0u) { if (xb_ld(&(bar)[XB_TMO])) break; if (_sp > XB_SPIN_CAP) { atomicAdd(&(bar)[XB_TMO], 1u); break; } } } } while (0)

struct XcdBarrier {
    unsigned* bar; unsigned x;
    volatile LAS unsigned* st;
};

__device__ __forceinline__ XcdBarrier xcd_barrier_post(unsigned* bar, volatile LAS unsigned* st) {
    XcdBarrier b; b.bar = bar; b.x = xb_xcc_id(); b.st = st;
    if (threadIdx.x == 0) (void)xb_add(&bar[XB_XCNT(b.x)], 1u);
    return b;
}
__device__ __forceinline__ void xcd_barrier_complete(unsigned* bar, unsigned x, unsigned& nloc, unsigned& nx) {
    const unsigned G = gridDim.x * gridDim.y * gridDim.z;
    unsigned sum, cnt, mine, sp = 0u;
    for (;;) {
        sum = 0u; cnt = 0u; mine = 0u;
#pragma unroll
        for (unsigned j = 0; j < 16; ++j) { const unsigned c = xb_ld(&bar[XB_XCNT(j)]); sum += c; cnt += (c > 0u) ? 1u : 0u; mine = (j == x) ? c : mine; }
        if (sum == G) break;
        __builtin_amdgcn_s_sleep(1);
        if ((++sp & 255u) == 0u) { if (xb_ld(&bar[XB_TMO])) break; if (sp > XB_SPIN_CAP) { atomicAdd(&bar[XB_TMO], 1u); break; } }
    }
    nloc = mine > 0u ? mine : 1u; nx = cnt > 0u ? cnt : 1u;
}

__device__ __forceinline__ void xcd_barrier(const XcdBarrier& b) {
    asm volatile("s_waitcnt vmcnt(0)" ::: "memory");
    __syncthreads();
    if (threadIdx.x == 0) {
        unsigned* bar = b.bar;
        __builtin_amdgcn_s_waitcnt(0);
        unsigned nloc = b.st[0], nx = b.st[1];
        if (nloc == 0u) { xcd_barrier_complete(bar, b.x, nloc, nx); b.st[0] = nloc; b.st[1] = nx; }
        const unsigned old = xb_add(&bar[XB_XSUB(b.x)], 1u);
        const unsigned gen = old / nloc;
        if (old + 1u == (gen + 1u) * nloc) {
            __builtin_amdgcn_fence(__ATOMIC_RELEASE, "agent");
            asm volatile("s_waitcnt vmcnt(0)" ::: "memory");
            const unsigned og = xb_add(&bar[XB_TOP], 1u);
            const unsigned tg = og / nx;
            if (og + 1u == (tg + 1u) * nx) xb_add(&bar[XB_TOPGEN], 1u);
            else XB_SPIN(xb_ld(&bar[XB_TOPGEN]) == tg, bar);
            __builtin_amdgcn_fence(__ATOMIC_ACQUIRE, "agent");
            xb_add(&bar[XB_XGEN(b.x)], 1u);
            asm volatile("s_waitcnt vmcnt(0)" ::: "memory");
        } else {
            XB_SPIN(xb_ld(&bar[XB_XGEN(b.x)]) == gen, bar);
            __builtin_amdgcn_fence(__ATOMIC_ACQUIRE, "agent");
            asm volatile("s_waitcnt vmcnt(0)" ::: "memory");
        }
    }
    __syncthreads();
}


struct Ctx {
    LAS unsigned char* lds;
    int tid, lane, wave, G, bid;
};
__device__ __forceinline__ const float* karg(int k) {
    const float* p; const unsigned long long ka = (unsigned long long)__builtin_amdgcn_kernarg_segment_ptr();
    asm volatile("s_load_dwordx2 %0, %1, %2\n\ts_waitcnt lgkmcnt(0)" : "=s"(p) : "s"(ka), "i"(8 * k) : "memory");
    return p;
}
__device__ __forceinline__ unsigned char* kws() { unsigned char* p; const unsigned long long ka = (unsigned long long)__builtin_amdgcn_kernarg_segment_ptr();
    asm volatile("s_load_dwordx2 %0, %1, 200\n\ts_waitcnt lgkmcnt(0)" : "=s"(p) : "s"(ka) : "memory"); return p; }
__device__ __forceinline__ float* kout() { float* p; const unsigned long long ka = (unsigned long long)__builtin_amdgcn_kernarg_segment_ptr();
    asm volatile("s_load_dwordx2 %0, %1, 192\n\ts_waitcnt lgkmcnt(0)" : "=s"(p) : "s"(ka) : "memory"); return p; }
__device__ __forceinline__ int opqv(int v) { asm volatile("" : "+v"(v)); return v; }
__device__ __forceinline__ int seq_of(int m) { return m < MP ? (m >> 11) : NP + ((m - MP) >> 3); }

__device__ __forceinline__ void p0_transpose_item(const float* W, int K, int N, bf16* WT, LAS float* scr, int item, int lane) {
    const int nblk = N / 32, kb = item / nblk, nb = item % nblk, k0 = 64 * kb, n0 = 32 * nb;
#pragma unroll 8
    for (int i = 0; i < 32; ++i) { const int kk = 2 * i + (lane >> 5); scr[kk * 33 + (lane & 31)] = W[(size_t)(k0 + kk) * N + n0 + (lane & 31)]; }
    LDS_WAIT(); asm volatile("" ::: "memory");
    const int c = lane & 7;
#pragma unroll
    for (int j = 0; j < 4; ++j) { const int n = (lane >> 3) + 8 * j; const LAS float* s = scr + (8 * c) * 33 + n;
        v4u o; o.x = pk2(s[0 * 33], s[1 * 33]); o.y = pk2(s[2 * 33], s[3 * 33]); o.z = pk2(s[4 * 33], s[5 * 33]); o.w = pk2(s[6 * 33], s[7 * 33]);
        *(v4u*)(WT + (size_t)(n0 + n) * K + k0 + 8 * c) = o; }
    LDS_WAIT(); asm volatile("" ::: "memory");
}
__device__ __forceinline__ void p0a_prologue(Ctx& F) {
    unsigned char* const ws = kws();
    const int lane = opqv(F.lane);
    LAS float* scr = (LAS float*)(F.lds + F.wave * 16384);
    const int gw = F.bid * NWAVES + F.wave, NGW = F.G * NWAVES;
    int start = 0;
    for (int l = 0; l < NL; ++l) {
#pragma unroll 1
        for (int mat = 0; mat < 5; ++mat) {
            const float* W; bf16* WT; int K, N;
            if (mat == 0)      { W = karg(12)   + (size_t)l * DM * INC;  WT = ((bf16*)(ws + WS_WIN))  + (size_t)l * INC * DM;  K = DM; N = INC; }
            else if (mat == 1) { W = karg(19)  + (size_t)l * DM * DM;   WT = ((bf16*)(ws + WS_WOUT)) + (size_t)l * DM * DM;   K = DM; N = DM; }
            else if (mat == 2) { W = karg(20)   + (size_t)l * DM * FF2;  WT = ((bf16*)(ws + WS_WUP))  + (size_t)l * FF2 * DM;  K = DM; N = FF2; }
            else if (mat == 3) { W = karg(23) + (size_t)l * FF * DM;   WT = ((bf16*)(ws + WS_WDN))  + (size_t)l * DM * FF;   K = FF; N = DM; }
            else               { W = karg(6)  + (size_t)l * DM * NMOD; WT = ((bf16*)(ws + WS_WADA)) + (size_t)l * NMOD * DM; K = DM; N = NMOD; }
            const int nitems = (K / 64) * (N / 32);
            int first = gw - start; if (first < 0) first += NGW;
            for (int it = first; it < nitems; it += NGW) p0_transpose_item(W, K, N, WT, scr, it, lane);
            start = (start + nitems) % NGW;
        }
    }
    for (int r = gw; r < 256; r += NGW) {
        v2u* o = (v2u*)(((bf16*)(ws + WS_SC)) + (size_t)r * DM) + lane;
        if (r < NSEQ) { const f32x4* c = (const f32x4*)(r < NP ? karg(4) + (size_t)r * DM : karg(5) + (size_t)(r - NP) * DM) + lane;
#pragma unroll
            for (int j = 0; j < 8; ++j) { const f32x4 v = c[64 * j]; v2u w; w.x = pk2(silu_f(v.x), silu_f(v.y)); w.y = pk2(silu_f(v.z), silu_f(v.w)); o[64 * j] = w; } }
        else {
#pragma unroll
            for (int j = 0; j < 8; ++j) o[64 * j] = (v2u){0u, 0u}; }
    }
}
__device__ __forceinline__ const float* x_in_row(const Ctx& F, int m) { return m < MP ? karg(0) + (size_t)m * DM : karg(1) + (size_t)(m - MP) * DM; }
__device__ __forceinline__ void norm_mod_store(const f32x4 (&x)[8], const float* g, const float* sc, const float* sh, bf16* hrow, int lane) {
    float ss = 0.f;
#pragma unroll
    for (int j = 0; j < 8; ++j) ss += (x[j].x * x[j].x + x[j].y * x[j].y) + (x[j].z * x[j].z + x[j].w * x[j].w);
    const float rs = __builtin_amdgcn_rsqf(wave_sum(ss) * (1.0f / DM) + EPS);
    v2u* o = (v2u*)hrow + lane;
#pragma unroll
    for (int j = 0; j < 8; ++j) { const f32x4 gv = ((const f32x4*)g)[lane + 64 * j], sv = ((const f32x4*)sc)[lane + 64 * j], hv = ((const f32x4*)sh)[lane + 64 * j];
        const f32x4 h = x[j] * rs * gv * (sv + 1.0f) + hv; v2u w; w.x = pk2(h.x, h.y); w.y = pk2(h.z, h.w); o[64 * j] = w; }
}
__device__ __forceinline__ void p0c_h0(Ctx& F) {
    unsigned char* const ws = kws();
    const int lane = opqv(F.lane);
    const int gw = F.bid * NWAVES + F.wave, NGW = F.G * NWAVES;
    for (int m = gw; m < M; m += NGW) {
        const float* mod = ((float*)(ws + WS_MOD)) + (size_t)seq_of(m) * NMODALL;
        const f32x4* xr = (const f32x4*)x_in_row(F, m) + lane; f32x4 x[8];
#pragma unroll
        for (int j = 0; j < 8; ++j) x[j] = xr[64 * j];
        norm_mod_store(x, karg(8), mod + DM, mod, ((bf16*)(ws + WS_H)) + (size_t)m * DM, lane);
    }
}
template <bool MID> __device__ __forceinline__ void row_update(Ctx& F, int l) {
    unsigned char* const ws = kws();
    float* const out = kout();
    const int lane = opqv(F.lane);
    const int gw = F.bid * NWAVES + F.wave, NGW = F.G * NWAVES;
    const bool fin = !MID && (l == NL - 1);
    const float* gpost = (MID ? karg(9) : karg(11)) + (size_t)l * DM;
    const float* gpre = MID ? karg(10) + (size_t)l * DM : karg(8) + (size_t)(l + 1 < NL ? l + 1 : l) * DM;
    for (int m = gw; m < M; m += NGW) {
        const float* mod = ((float*)(ws + WS_MOD)) + (size_t)seq_of(m) * NMODALL + (size_t)l * NMOD;
        const float* gt = mod + (MID ? 2 : 5) * DM;
        const float* sc = MID ? mod + 4 * DM : mod + NMOD + DM;
        const float* sh = MID ? mod + 3 * DM : mod + NMOD;
        const f32x4* yr = (const f32x4*)(((float*)(ws + WS_Y)) + (size_t)m * DM) + lane;
        const f32x4* xr = (const f32x4*)((MID && l == 0) ? x_in_row(F, m) : ((float*)(ws + WS_X)) + (size_t)m * DM) + lane;
        f32x4 y[8], x[8]; float ss = 0.f;
#pragma unroll
        for (int j = 0; j < 8; ++j) { y[j] = yr[64 * j]; x[j] = xr[64 * j]; }
        if (m >= MP) {
            const f32x4* pr = (const f32x4*)(((float*)(ws + WS_PART)) + (size_t)(m - MP) * DM) + lane;
#pragma unroll
            for (int j = 0; j < 8; ++j) y[j] = pr[64 * j];
#pragma unroll 1
            for (int ks = 1; ks < 8; ++ks) {
#pragma unroll
                for (int j = 0; j < 8; ++j) y[j] = y[j] + pr[(size_t)ks * (MS * DM / 4) + 64 * j]; }
        }
#pragma unroll
        for (int j = 0; j < 8; ++j) ss += (y[j].x * y[j].x + y[j].y * y[j].y) + (y[j].z * y[j].z + y[j].w * y[j].w);
        const float rs = __builtin_amdgcn_rsqf(wave_sum(ss) * (1.0f / DM) + EPS);
#pragma unroll
        for (int j = 0; j < 8; ++j) { const f32x4 gp = ((const f32x4*)gpost)[lane + 64 * j], gv = ((const f32x4*)gt)[lane + 64 * j]; x[j] = x[j] + gv * (y[j] * rs * gp); }
        if (fin) { f32x4* o = (f32x4*)(out + (size_t)m * DM) + lane;
#pragma unroll
            for (int j = 0; j < 8; ++j) o[64 * j] = x[j]; }
        else { f32x4* o = (f32x4*)(((float*)(ws + WS_X)) + (size_t)m * DM) + lane;
#pragma unroll
            for (int j = 0; j < 8; ++j) o[64 * j] = x[j];
            norm_mod_store(x, gpre, sc, sh, ((bf16*)(ws + WS_H)) + (size_t)m * DM, lane); }
    }
}
__device__ __forceinline__ s16x4 lds_tr16(LAS unsigned char* p) { return __builtin_bit_cast(s16x4, __builtin_amdgcn_ds_read_tr16_b64_v4i16((LAS s16x4*)p)); }
__device__ __forceinline__ void mixer_a_unit(Ctx& F, int l, int u) {
    unsigned char* const ws = kws();
    float* const out = kout();
    const int lane = opqv(F.lane), h = F.wave;
    const bool samp = u >= 64;
    const int bsel = u >> 4, ci = u & 15;
    const int m0 = samp ? MP + (u - 64) * 128 : bsel * TP + ci * 128;
    const bf16* P = ((bf16*)(ws + WS_PROJ)) + (size_t)m0 * INC;
    LAS float* R = (LAS float*)(F.lds + TAB_OFF);
    LAS float* SSQ = R + 128;
    __syncthreads();
    {
        const float* gv = karg(13) + (size_t)l * WA;
        const bool wr_rows = samp || ci == 15;
        for (int i = 0; i < 16; ++i) {
            const int s = 16 * h + i;
            const bf16* vr = P + (size_t)s * INC + WA;
            const v4u a = *(const v4u*)(vr + 8 * lane), b = *(const v4u*)(vr + 512 + 8 * lane);
            float fa[8], fb[8]; unpack8(a, fa); unpack8(b, fb);
            float ss = 0.f;
#pragma unroll
            for (int j = 0; j < 8; ++j) ss += fa[j] * fa[j] + fb[j] * fb[j];
            const float r = __builtin_amdgcn_rsqf(wave_sum(ss) * (1.0f / WA) + EPS);
            if (lane == 0) R[s] = r;
            if (wr_rows) {
                float* o = samp ? out + O_CVS + ((size_t)(((u - 64) * 16 + (s >> 3)) * NL + l) * TS + (s & 7)) * WA
                                : out + O_CVP + ((size_t)(bsel * NL + l) * 128 + s) * WA;
                const f32x4 g0 = *(const f32x4*)(gv + 8 * lane), g1 = *(const f32x4*)(gv + 8 * lane + 4), g2 = *(const f32x4*)(gv + 512 + 8 * lane), g3 = *(const f32x4*)(gv + 512 + 8 * lane + 4);
                *(f32x4*)(o + 8 * lane) = (f32x4){fa[0], fa[1], fa[2], fa[3]} * r * g0; *(f32x4*)(o + 8 * lane + 4) = (f32x4){fa[4], fa[5], fa[6], fa[7]} * r * g1;
                *(f32x4*)(o + 512 + 8 * lane) = (f32x4){fb[0], fb[1], fb[2], fb[3]} * r * g2; *(f32x4*)(o + 512 + 8 * lane + 4) = (f32x4){fb[4], fb[5], fb[6], fb[7]} * r * g3;
            }
        }
    }
    __syncthreads();
    LAS unsigned char* vt = F.lds + h * 16384;
    const float* Wsp = karg(14) + ((size_t)l * 8 + h) * 128 * 128;
    const float* bsp = karg(15) + (size_t)(l * 8 + h) * 128;
    const float* gvh = karg(13) + (size_t)l * WA + 128 * h;
    const float* gah = karg(17) + (size_t)l * WA + 128 * h;
    const int g = lane >> 4, i16 = lane & 15, q = i16 >> 2, p = i16 & 3;
#pragma unroll 1
    for (int dh = 0; dh < 2; ++dh) {
#pragma unroll
        for (int it = 0; it < 16; ++it) { const int s = it * 8 + (lane >> 3);
            const v4u x = *(const v4u*)(P + (size_t)s * INC + WA + 128 * h + 64 * dh + 8 * (lane & 7));
            *(LAS v4u*)(vt + s * 128 + (lane & 7) * 16) = x; }
        LDS_WAIT(); asm volatile("" ::: "memory");
        bf16x8 vf[4][4];
#pragma unroll
        for (int ks = 0; ks < 4; ++ks)
#pragma unroll
            for (int nt = 0; nt < 4; ++nt) { LAS unsigned char* a = vt + (32 * ks + 8 * g + q) * 128 + (16 * nt + 4 * p) * 2;
                const s16x4 lo = lds_tr16(a), hi = lds_tr16(a + 4 * 128);
                vf[ks][nt] = (bf16x8){lo[0], lo[1], lo[2], lo[3], hi[0], hi[1], hi[2], hi[3]}; }
#pragma unroll 1
        for (int tm = 0; tm < 8; ++tm) {
            const int t = 16 * tm + i16;
            const int tl = samp ? (t & 7) : t;
            const int nks = (tm >> 1) + 1;
            f32x4 acc[4];
#pragma unroll
            for (int nt = 0; nt < 4; ++nt) acc[nt] = (f32x4){0.f, 0.f, 0.f, 0.f};
#pragma unroll
            for (int ks = 0; ks < 4; ++ks) {
                if (ks < nks) {
                    const int s0 = 32 * ks + 8 * g;
                    const int sl0 = samp ? 0 : s0;
                    const bool blk = samp ? ((s0 >> 3) == (t >> 3)) : true;
                    const float* wp = Wsp + (size_t)tl * 128 + sl0;
                    const f32x4 w0 = *(const f32x4*)wp, w1 = *(const f32x4*)(wp + 4);
                    float w[8] = {w0.x, w0.y, w0.z, w0.w, w1.x, w1.y, w1.z, w1.w};
                    const f32x4 r0 = *(const LAS f32x4*)(R + s0), r1 = *(const LAS f32x4*)(R + s0 + 4);
                    const float rr[8] = {r0.x, r0.y, r0.z, r0.w, r1.x, r1.y, r1.z, r1.w};
#pragma unroll
                    for (int j = 0; j < 8; ++j) w[j] = (blk && (sl0 + j <= tl)) ? w[j] * rr[j] : 0.f;
                    v4u ww; ww.x = pk2(w[0], w[1]); ww.y = pk2(w[2], w[3]); ww.z = pk2(w[4], w[5]); ww.w = pk2(w[6], w[7]);
                    const bf16x8 wf = __builtin_bit_cast(bf16x8, ww);
#pragma unroll
                    for (int nt = 0; nt < 4; ++nt) acc[nt] = __builtin_amdgcn_mfma_f32_16x16x32_bf16(vf[ks][nt], wf, acc[nt], 0, 0, 0);
                }
            }
            const float bias = bsp[tl];
            const size_t m = (size_t)m0 + t;
            float ss = 0.f;
#pragma unroll
            for (int nt = 0; nt < 4; ++nt) {
                const int d = 64 * dh + 16 * nt + 4 * g;
                const v2u uw = *(const v2u*)(P + (size_t)t * INC + 128 * h + d);
                const f32x4 uu = (f32x4){bflo(uw.x), bfhi(uw.x), bflo(uw.y), bfhi(uw.y)};
                const f32x4 gv4 = *(const f32x4*)(gvh + d), ga4 = *(const f32x4*)(gah + d);
                const f32x4 o = uu * (acc[nt] * gv4 + bias);
                ss += (o.x * o.x + o.y * o.y) + (o.z * o.z + o.w * o.w);
                const f32x4 og = o * ga4; v2u w2; w2.x = pk2(og.x, og.y); w2.y = pk2(og.z, og.w);
                *(v2u*)(((bf16*)(ws + WS_MRG)) + m * DM + 128 * h + d) = w2;
            }
            ss += __shfl_xor(ss, 16); ss += __shfl_xor(ss, 32);
            if (g == 0) SSQ[(t * 8 + h) * 2 + dh] = ss;
        }
        LDS_WAIT(); asm volatile("" ::: "memory");
    }
    __syncthreads();
    for (int i = 0; i < 16; ++i) {
        const int s = 16 * h + i;
        const LAS f32x4* qq = (const LAS f32x4*)(SSQ + s * 16); const f32x4 q0 = qq[0], q1 = qq[1], q2 = qq[2], q3 = qq[3];
        const float tot = (((q0.x + q0.y) + (q0.z + q0.w)) + ((q1.x + q1.y) + (q1.z + q1.w))) + (((q2.x + q2.y) + (q2.z + q2.w)) + ((q3.x + q3.y) + (q3.z + q3.w)));
        const float ra = __builtin_amdgcn_rsqf(tot * (1.0f / WA) + EPS);
        bf16* row = ((bf16*)(ws + WS_MRG)) + ((size_t)m0 + s) * DM;
        float fa[8], fb[8]; unpack8(*(const v4u*)(row + 8 * lane), fa); unpack8(*(const v4u*)(row + 512 + 8 * lane), fb);
#pragma unroll
        for (int j = 0; j < 8; ++j) { fa[j] *= ra; fb[j] *= ra; }
        *(v4u*)(row + 8 * lane) = pack8(fa); *(v4u*)(row + 512 + 8 * lane) = pack8(fb);
    }
}
__device__ __forceinline__ void load16f(const float* p, int lane, float (&f)[16]) {
    const f32x4 a = *(const f32x4*)(p + 8 * lane), b = *(const f32x4*)(p + 8 * lane + 4), c = *(const f32x4*)(p + 512 + 8 * lane), d = *(const f32x4*)(p + 512 + 8 * lane + 4);
    f[0] = a.x; f[1] = a.y; f[2] = a.z; f[3] = a.w; f[4] = b.x; f[5] = b.y; f[6] = b.z; f[7] = b.w; f[8] = c.x; f[9] = c.y; f[10] = c.z; f[11] = c.w; f[12] = d.x; f[13] = d.y; f[14] = d.z; f[15] = d.w;
}
__device__ __forceinline__ void load16b(const bf16* p, int lane, float (&f)[16]) {
    float a[8], b[8]; unpack8(*(const v4u*)(p + 8 * lane), a); unpack8(*(const v4u*)(p + 512 + 8 * lane), b);
#pragma unroll
    for (int j = 0; j < 8; ++j) { f[j] = a[j]; f[8 + j] = b[j]; }
}
__device__ __forceinline__ void store16f(float* p, int lane, const float (&f)[16]) {
    *(f32x4*)(p + 8 * lane) = (f32x4){f[0], f[1], f[2], f[3]}; *(f32x4*)(p + 8 * lane + 4) = (f32x4){f[4], f[5], f[6], f[7]};
    *(f32x4*)(p + 512 + 8 * lane) = (f32x4){f[8], f[9], f[10], f[11]}; *(f32x4*)(p + 512 + 8 * lane + 4) = (f32x4){f[12], f[13], f[14], f[15]};
}
__device__ __forceinline__ void mixer_b_item(Ctx& F, int l, int seg) {
    unsigned char* const ws = kws();
    float* const out = kout();
    const int lane = opqv(F.lane);
    const int m0 = seg * 8;
    const bool samp = m0 >= MP;
    const int b = samp ? (m0 - MP) >> 3 : m0 >> 11, t0 = samp ? 0 : (m0 & (TP - 1));
    float w0[16], w1[16], w2[16], gb[16], p2[16], p1[16];
    load16f(karg(16) + (size_t)l * 3 * WB, lane, w0); load16f(karg(16) + (size_t)l * 3 * WB + WB, lane, w1); load16f(karg(16) + (size_t)l * 3 * WB + 2 * WB, lane, w2);
    load16f(karg(18) + (size_t)l * WB, lane, gb);
    if (samp) { const float* st = karg(2) + (size_t)(b * NL + l) * 2 * WB; load16f(st, lane, p2); load16f(st + WB, lane, p1); }
    else if (t0 == 0) {
#pragma unroll
        for (int j = 0; j < 16; ++j) { p2[j] = 0.f; p1[j] = 0.f; } }
    else { float a[16], c[16];
        load16b(((bf16*)(ws + WS_PROJ)) + (size_t)(m0 - 2) * INC + 3072, lane, a); load16b(((bf16*)(ws + WS_PROJ)) + (size_t)(m0 - 2) * INC + 4096, lane, c);
#pragma unroll
        for (int j = 0; j < 16; ++j) p2[j] = a[j] * c[j];
        load16b(((bf16*)(ws + WS_PROJ)) + (size_t)(m0 - 1) * INC + 3072, lane, a); load16b(((bf16*)(ws + WS_PROJ)) + (size_t)(m0 - 1) * INC + 4096, lane, c);
#pragma unroll
        for (int j = 0; j < 16; ++j) p1[j] = a[j] * c[j]; }
    const bool tail = samp || (t0 + 8 == TP);
    float* omix = (samp ? out + O_MIXS : out + O_MIXP) + (size_t)(b * NL + l) * 2 * WB;
#pragma unroll
    for (int r = 0; r < 8; ++r) {
        const bf16* pr = ((bf16*)(ws + WS_PROJ)) + (size_t)(m0 + r) * INC;
        float gbv[16], gc[16], hb[16], cin[16], ob[16];
        load16b(pr + 2048, lane, gbv); load16b(pr + 3072, lane, gc); load16b(pr + 4096, lane, hb);
        float ss = 0.f;
#pragma unroll
        for (int j = 0; j < 16; ++j) { cin[j] = gc[j] * hb[j]; ob[j] = gbv[j] * (w0[j] * p2[j] + w1[j] * p1[j] + w2[j] * cin[j]); ss += ob[j] * ob[j]; }
        const float rb = __builtin_amdgcn_rsqf(wave_sum(ss) * (1.0f / WB) + EPS);
        float oa[8], oc[8];
#pragma unroll
        for (int j = 0; j < 8; ++j) { oa[j] = ob[j] * rb * gb[j]; oc[j] = ob[8 + j] * rb * gb[8 + j]; }
        bf16* mr = ((bf16*)(ws + WS_MRG)) + (size_t)(m0 + r) * DM + WA;
        *(v4u*)(mr + 8 * lane) = pack8(oa); *(v4u*)(mr + 512 + 8 * lane) = pack8(oc);
        if (tail && r >= 6) store16f(omix + (size_t)(r - 6) * WB, lane, cin);
#pragma unroll
        for (int j = 0; j < 16; ++j) { p2[j] = p1[j]; p1[j] = cin[j]; }
    }
}
__device__ __forceinline__ void p2_mixer(Ctx& F, int l) {
    constexpr int NA = 72, NBB = (M / 8) / NWAVES;
    for (int u = F.bid; u < NA + NBB; u += F.G) {
        if (u < NA) { MA(mixer_a_unit(F, l, u)); }
        else { MB(mixer_b_item(F, l, (u - NA) * NWAVES + F.wave)); }
    }
}
__device__ __forceinline__ void conv_ffn_item(Ctx& F, int l, int item) {
    unsigned char* const ws = kws();
    float* const out = kout();
    const int lane = opqv(F.lane);
    const int seg = item / 11, cc = item - seg * 11;
    const bool samp = seg >= 512;
    const int b = samp ? seg - 512 : seg >> 7, t0 = samp ? 0 : (seg & 127) * 16, nrows = samp ? 8 : 16;
    const int m0 = samp ? MP + b * 8 : seg * 16;
    const int jg = cc * 512 + 8 * lane, jv = FF + jg;
    const float* wc = karg(21) + (size_t)l * 3 * FF2; const float* bc = karg(22) + (size_t)l * FF2;
    float w0g[8], w1g[8], w2g[8], bg[8], w0v[8], w1v[8], w2v[8], bv[8], g2[8], g1[8], v2[8], v1[8];
#define LD8F(dst, ptr) do { const f32x4 _a = *(const f32x4*)(ptr), _b = *(const f32x4*)((ptr) + 4); dst[0] = _a.x; dst[1] = _a.y; dst[2] = _a.z; dst[3] = _a.w; dst[4] = _b.x; dst[5] = _b.y; dst[6] = _b.z; dst[7] = _b.w; } while (0)
    LD8F(w0g, wc + jg); LD8F(w1g, wc + FF2 + jg); LD8F(w2g, wc + 2 * FF2 + jg); LD8F(bg, bc + jg);
    LD8F(w0v, wc + jv); LD8F(w1v, wc + FF2 + jv); LD8F(w2v, wc + 2 * FF2 + jv); LD8F(bv, bc + jv);
    if (samp) { const float* st = karg(3) + (size_t)(b * NL + l) * 2 * FF2; LD8F(g2, st + jg); LD8F(v2, st + jv); LD8F(g1, st + FF2 + jg); LD8F(v1, st + FF2 + jv); }
    else if (t0 == 0) {
#pragma unroll
        for (int j = 0; j < 8; ++j) { g2[j] = 0.f; g1[j] = 0.f; v2[j] = 0.f; v1[j] = 0.f; } }
    else { unpack8(*(const v4u*)(((bf16*)(ws + WS_UP)) + (size_t)(m0 - 2) * FF2 + jg), g2); unpack8(*(const v4u*)(((bf16*)(ws + WS_UP)) + (size_t)(m0 - 2) * FF2 + jv), v2);
           unpack8(*(const v4u*)(((bf16*)(ws + WS_UP)) + (size_t)(m0 - 1) * FF2 + jg), g1); unpack8(*(const v4u*)(((bf16*)(ws + WS_UP)) + (size_t)(m0 - 1) * FF2 + jv), v1); }
    const bool tail = samp || (t0 + 16 == TP);
    float* offn = (samp ? out + O_FFNS : out + O_FFNP) + (size_t)(b * NL + l) * 2 * FF2;
#pragma unroll 2
    for (int r = 0; r < nrows; ++r) {
        float xg[8], xv[8], a[8];
        unpack8(*(const v4u*)(((bf16*)(ws + WS_UP)) + (size_t)(m0 + r) * FF2 + jg), xg); unpack8(*(const v4u*)(((bf16*)(ws + WS_UP)) + (size_t)(m0 + r) * FF2 + jv), xv);
#pragma unroll
        for (int j = 0; j < 8; ++j) { const float G = w0g[j] * g2[j] + w1g[j] * g1[j] + w2g[j] * xg[j] + bg[j], V = w0v[j] * v2[j] + w1v[j] * v1[j] + w2v[j] * xv[j] + bv[j]; a[j] = silu_f(G) * V; }
        *(v4u*)(((bf16*)(ws + WS_ACT)) + (size_t)(m0 + r) * FF + jg) = pack8(a);
        if (tail && r >= nrows - 2) { float* o = offn + (size_t)(r - (nrows - 2)) * FF2;
            *(f32x4*)(o + jg) = (f32x4){xg[0], xg[1], xg[2], xg[3]}; *(f32x4*)(o + jg + 4) = (f32x4){xg[4], xg[5], xg[6], xg[7]};
            *(f32x4*)(o + jv) = (f32x4){xv[0], xv[1], xv[2], xv[3]}; *(f32x4*)(o + jv + 4) = (f32x4){xv[4], xv[5], xv[6], xv[7]}; }
#pragma unroll
        for (int j = 0; j < 8; ++j) { g2[j] = g1[j]; g1[j] = xg[j]; v2[j] = v1[j]; v1[j] = xv[j]; }
    }
#undef LD8F
}
__device__ __forceinline__ void p6_conv_ffn(Ctx& F, int l) {
    const int gw = F.bid * NWAVES + F.wave, NGW = F.G * NWAVES;
    constexpr int NITEMS = (512 + NS) * 11;
    for (int it = gw; it < NITEMS; it += NGW) conv_ffn_item(F, l, it);
}
#ifdef NO_G0
#define GG0(...)
#else
#define GG0(...) __VA_ARGS__
#endif
#ifdef NO_G1
#define GG1(...)
#else
#define GG1(...) __VA_ARGS__
#endif
#ifdef NO_G2
#define GG2(...)
#else
#define GG2(...) __VA_ARGS__
#endif
#ifdef NO_G3
#define GG3(...)
#else
#define GG3(...) __VA_ARGS__
#endif
#ifdef NO_G4
#define GG4(...)
#else
#define GG4(...) __VA_ARGS__
#endif
#ifdef NO_T0
#define T0(...)
#else
#define T0(...) __VA_ARGS__
#endif
#ifdef NO_T1
#define T1(...)
#else
#define T1(...) __VA_ARGS__
#endif
#ifdef NO_T2
#define T2(...)
#else
#define T2(...) __VA_ARGS__
#endif
#ifdef NO_T3
#define T3(...)
#else
#define T3(...) __VA_ARGS__
#endif
#ifdef NO_T4
#define T4(...)
#else
#define T4(...) __VA_ARGS__
#endif
#ifdef NO_T5
#define T5(...)
#else
#define T5(...) __VA_ARGS__
#endif

__device__ __forceinline__ int opq(int v) { asm volatile("" : "+s"(v)); return v; }
struct Args { const float* in[24]; float* out; unsigned char* ws; int ph_lo, ph_hi; };
__global__ void __launch_bounds__(NTHREADS, 2) fwd(Args args) {
    extern __shared__ __attribute__((aligned(16))) unsigned char lds_raw[];
    Ctx F;
    F.lds = (LAS unsigned char*)lds_raw;
    volatile LAS unsigned* MISC = (volatile LAS unsigned*)(F.lds + MISC_OFF);
    F.tid = threadIdx.x; F.lane = F.tid & 63; F.wave = __builtin_amdgcn_readfirstlane(F.tid >> 6);
    F.G = gridDim.x; F.bid = blockIdx.x;
    gu32* ctl = (gu32*)(args.ws + WS_CTL);
    for (int u = F.tid; u < (LDS_BYTES - MISC_OFF) / 4; u += NTHREADS) ((LAS unsigned*)(F.lds + MISC_OFF))[u] = 0u;
    __syncthreads();
#if MK_PER_PHASE
#define SEAM(k) do { } while (0)
#else
    XcdBarrier bar = xcd_barrier_post((unsigned*)(ctl + CW_BAR), MISC + 8);
#define SEAM(k) do { if (lo <= (k) && (k) + 1 < hi) xcd_barrier(bar); } while (0)
#endif
    const int lo = args.ph_lo, hi = args.ph_hi;
#define IN(k) (lo <= (k) && (k) < hi)
    if (IN(0)) { T0(p0a_prologue(F)); }
    SEAM(0);
    if (IN(1)) {
        pg8::Gemm g{((bf16*)(kws() + WS_SC)), ((bf16*)(kws() + WS_WADA)), 256, NMODALL, DM}; pg8::StaticOrder S; S.init(256, NMODALL, DM, F.G, opq(F.bid));
        pg8::EpiF32 E{((float*)(kws() + WS_MOD)), NMODALL, karg(7), nullptr};
        GG0(pg8::gemm_phase<pg8::EpiF32, pg8::StaticOrder, true, true>(F.lds, g, S, E);)
    }
    SEAM(1);
    if (IN(2)) { T1(p0c_h0(F)); }
    SEAM(2);
#pragma unroll 1
    for (int l = 0; l < NL; ++l) {
        const int pb = 3 + 8 * l;
        if (IN(pb + 0)) {
            pg8::Gemm g{((bf16*)(kws() + WS_H)), ((bf16*)(kws() + WS_WIN)) + (size_t)l * INC * DM, M, INC, DM}; pg8::StaticOrder S; S.init(M, INC, DM, F.G, opq(F.bid));
            pg8::EpiBf16G E{((bf16*)(kws() + WS_PROJ)), INC, 8};
            GG1(pg8::gemm_phase<pg8::EpiBf16G, pg8::StaticOrder, true, true>(F.lds, g, S, E);)
        }
        SEAM(pb + 0);
        if (IN(pb + 1)) { T2(p2_mixer(F, l)); }
        SEAM(pb + 1);
        if (IN(pb + 2)) {
            pg8::Gemm g{((bf16*)(kws() + WS_MRG)), ((bf16*)(kws() + WS_WOUT)) + (size_t)l * DM * DM, M, DM, DM}; pg8::SplitOrder S; S.init(DM, F.G, opq(F.bid));
            pg8::EpiF32 E{((float*)(kws() + WS_Y)), DM, nullptr, ((float*)(kws() + WS_PART))};
            GG2(pg8::gemm_phase<pg8::EpiF32, pg8::SplitOrder, true, true>(F.lds, g, S, E);)
        }
        SEAM(pb + 2);
        if (IN(pb + 3)) { T3(row_update<true>(F, l)); }
        SEAM(pb + 3);
        if (IN(pb + 4)) {
            pg8::Gemm g{((bf16*)(kws() + WS_H)), ((bf16*)(kws() + WS_WUP)) + (size_t)l * FF2 * DM, M, FF2, DM}; pg8::StaticOrder S; S.init(M, FF2, DM, F.G, opq(F.bid));
            pg8::EpiBf16G E{((bf16*)(kws() + WS_UP)), FF2, 0};
            GG3(pg8::gemm_phase<pg8::EpiBf16G, pg8::StaticOrder, true, true>(F.lds, g, S, E);)
        }
        SEAM(pb + 4);
        if (IN(pb + 5)) { T4(p6_conv_ffn(F, l)); }
        SEAM(pb + 5);
        if (IN(pb + 6)) {
            pg8::Gemm g{((bf16*)(kws() + WS_ACT)), ((bf16*)(kws() + WS_WDN)) + (size_t)l * DM * FF, M, DM, FF}; pg8::SplitOrder S; S.init(FF, F.G, opq(F.bid));
            pg8::EpiF32 E{((float*)(kws() + WS_Y)), DM, nullptr, ((float*)(kws() + WS_PART))};
            GG4(pg8::gemm_phase<pg8::EpiF32, pg8::SplitOrder, true, true>(F.lds, g, S, E);)
        }
        SEAM(pb + 6);
        if (IN(pb + 7)) { T5(row_update<false>(F, l)); }
        SEAM(pb + 7);
    }
#undef IN
#undef SEAM
}

extern "C" void kernel_launch(void* const* d_in, const int* in_sizes, int n_in, void* d_out, int out_size, void* d_ws, size_t ws_size, hipStream_t stream) {
    static int grid = 0;
    if (grid == 0) {
        if (n_in != 24 || in_sizes[0] != MP * DM || (size_t)out_size != O_END || ws_size < WS_END) {
            fprintf(stderr, "kernel_launch: unexpected shapes (n_in %d, in0 %d, out %d, ws %zu); nothing launched\n", n_in, n_in > 0 ? in_sizes[0] : -1, out_size, ws_size); grid = -1; return; }
        int dev = 0, cus = 0, per_cu = 0;
        if (hipGetDevice(&dev) != hipSuccess || hipDeviceGetAttribute(&cus, hipDeviceAttributeMultiprocessorCount, dev) != hipSuccess) { grid = -1; return; }
        if (hipFuncSetAttribute((const void*)fwd, hipFuncAttributeMaxDynamicSharedMemorySize, LDS_BYTES) != hipSuccess) { fprintf(stderr, "kernel_launch: hipFuncSetAttribute failed\n"); grid = -1; return; }
        if (hipOccupancyMaxActiveBlocksPerMultiprocessor(&per_cu, (const void*)fwd, NTHREADS, LDS_BYTES) != hipSuccess || per_cu < 1) { fprintf(stderr, "kernel_launch: occupancy query says %d blocks per CU\n", per_cu); }
        (void)hipGetLastError();
        grid = cus;
    }
    if (grid < 0) return;
    if (hipMemsetAsync((char*)d_ws + WS_CTL, 0, CTL_ZERO_BYTES, stream) != hipSuccess) return;
    Args a{};
    for (int i = 0; i < 24; ++i) a.in[i] = (const float*)d_in[i];
    a.out = (float*)d_out; a.ws = (unsigned char*)d_ws;
#if MK_PER_PHASE
    for (int p = 0; p < NPHASES; ++p) { a.ph_lo = p; a.ph_hi = p + 1; hipLaunchKernelGGL(fwd, dim3(grid), dim3(NTHREADS), LDS_BYTES, stream, a); }
#else
    a.ph_lo = 0; a.ph_hi = NPHASES;
    hipLaunchKernelGGL(fwd, dim3(grid), dim3(NTHREADS), LDS_BYTES, stream, a);
#endif
    const hipError_t le = hipPeekAtLastError();
    if (le != hipSuccess) fprintf(stderr, "kernel_launch: launch failed: %s\n", hipGetErrorName(le));
}
```

```cpp
#include <hip/hip_runtime.h>
#include <cstdio>
#include <cstdint>
#ifndef MK_PER_PHASE
#define MK_PER_PHASE 0
#endif
#ifndef REP_GEMM
#define REP_GEMM 1
#endif
#ifndef REP_PRO
#define REP_PRO 1
#endif
#ifndef REP_MIX
#define REP_MIX 1
#endif
#ifndef REP_CONV
#define REP_CONV 1
#endif
#define GG0(...) for (int _r = 0; _r < REP_GEMM; ++_r) { __VA_ARGS__ }
#define GG1(...) for (int _r = 0; _r < REP_GEMM; ++_r) { __VA_ARGS__ }
#define GG2(...) for (int _r = 0; _r < REP_GEMM; ++_r) { __VA_ARGS__ }
#define GG3(...) for (int _r = 0; _r < REP_GEMM; ++_r) { __VA_ARGS__ }
#define GG4(...) for (int _r = 0; _r < REP_GEMM; ++_r) { __VA_ARGS__ }
#define T0(...) for (int _r = 0; _r < REP_PRO; ++_r) { __VA_ARGS__; }
#define T1(...) __VA_ARGS__
#define T2(...) for (int _r = 0; _r < REP_MIX; ++_r) { __VA_ARGS__; }
#define T3(...) __VA_ARGS__
#define T4(...) for (int _r = 0; _r < REP_CONV; ++_r) { __VA_ARGS__; }
#define T5(...) __VA_ARGS__
#define MA(...) __VA_ARGS__
#define MB(...) __VA_ARGS__
namespace pg8 {
#define PG8_LAS __attribute__((address_space(3)))
typedef unsigned short bf16_t;
typedef short bf16x8 __attribute__((ext_vector_type(8)));
typedef float f32x4 __attribute__((ext_vector_type(4)));
typedef unsigned u32x4 __attribute__((ext_vector_type(4)));
constexpr int BM = 256, BK = 64, HALF = 128, HTB = HALF * BK * 2  , STAGE_BYTES = 8 * HTB, NXCD = 8, WGM = 8;

__host__ __device__ __forceinline__ int lds_byte(int r, int c) { const int st = (r >> 4) * 2 + (c >> 5), rr = r & 15, cc = c & 31, ob = rr * 64 + cc * 2; return st * 1024 + (ob ^ (((ob >> 9) & 1) << 5)); }
__host__ __device__ __forceinline__ void stage_rc(int b, int& R, int& C) { const int st = b / 1024, sb = b % 1024, swz = sb ^ (((sb >> 9) & 1) << 5); R = (st >> 1) * 16 + swz / 64; C = (st & 1) * 32 + (swz % 64) / 2; }
__host__ __device__ __forceinline__ int perm32(int rho) { const int n = rho >> 4, i = rho & 15; return 8 * (i >> 2) + 4 * n + (i & 3); }

struct Unit { int pm, pn, ks; };
struct Gemm { const bf16_t* A; const bf16_t* Bt; int M, N, K; };

struct StaticOrder {
    int nM, nN, nwg, G, c, KT;
    __host__ __device__ void init(int M, int N, int K, int G_, int c_) { nM = M / BM; nN = N / BM; nwg = nM * nN; G = G_; c = c_; KT = K / BK; }
    __host__ __device__ bool next(int i, Unit& u) const {
        const long L = (long)i * G + c; if (L >= nwg) return false;
        int wgid = (int)L; { const int q = nwg / NXCD, r = nwg % NXCD, xcd = wgid % NXCD, off = wgid / NXCD; wgid = (xcd < r ? xcd * (q + 1) : r * (q + 1) + (xcd - r) * q) + off; }
        const int nig = WGM * nN, gid = wgid / nig, fm = gid * WGM, gsz = (nM - fm) < WGM ? (nM - fm) : WGM;
        u.pm = fm + ((wgid % nig) % gsz); u.pn = (wgid % nig) / gsz; u.ks = -1; return true;
    }
    __device__ __forceinline__ int k0(const Unit&) const { return 0; }
    __device__ __forceinline__ int nt(const Unit&) const { return KT; }
    __device__ __forceinline__ void a_ready(const Unit&) const {}
    __device__ __forceinline__ void done(const Unit&) const {}
};
struct SplitOrder {
    int G, c, KB;
    __host__ __device__ void init(int K, int G_, int c_) { G = G_; c = c_; KB = K / 128; }
    __host__ __device__ bool next(int i, Unit& u) const {
        const int L = i * G + c; if (L >= 512) return false;
        if (L < 256) { const int x = L & 7, j = L >> 3; u.pm = 4 * x + (j >> 3); u.pn = j & 7; u.ks = -1; }
        else { const int Ls = L - 256, j = Ls >> 3; u.pm = 32 + (j >> 3); u.pn = j & 7; u.ks = Ls & 7; }
        return true;
    }
    __device__ __forceinline__ int k0(const Unit& u) const { const int base = KB >> 3, rem = KB & 7; return u.ks < 0 ? 0 : 128 * (u.ks * base + (u.ks < rem ? u.ks : rem)); }
    __device__ __forceinline__ int nt(const Unit& u) const { const int base = KB >> 3, rem = KB & 7; return u.ks < 0 ? 2 * KB : 2 * (base + (u.ks < rem ? 1 : 0)); }
    __device__ __forceinline__ void a_ready(const Unit&) const {}
    __device__ __forceinline__ void done(const Unit&) const {}
};

__device__ __forceinline__ unsigned cvt_pk_bf16(float lo, float hi) { unsigned r; asm volatile("v_cvt_pk_bf16_f32 %0, %1, %2" : "=v"(r) : "v"(lo), "v"(hi)); return r; }
typedef float f32x2 __attribute__((ext_vector_type(2)));
__device__ __forceinline__ float gelu_tanh(float x) {
    const float z = x * (1.5957691216f + 0.0713548163f * x * x);
    const float e = __builtin_amdgcn_exp2f(-1.4426950409f * z);
    return x * __builtin_amdgcn_rcpf(1.0f + e);
}
struct EpiBf16G {
    static constexpr bool PERM = true, AFTER_DRAIN = false;
    bf16_t* O; int ldc; int ngelu;
    __device__ __forceinline__ void operator()(const f32x4 (&acc)[2][2][4][2], const Unit& u, int wr, int wc, int fr, int fq) const {
        const int row0 = u.pm * BM + wr * 64 + fr; const int col0 = u.pn * BM + wc * 32 + 8 * fq;
        const bool act = u.pn < ngelu;
#pragma unroll
        for (int ai = 0; ai < 2; ++ai)
#pragma unroll
            for (int m = 0; m < 4; ++m) { bf16_t* rowp = O + (size_t)(row0 + ai * HALF + m * 16) * ldc + col0;
#pragma unroll
                for (int bj = 0; bj < 2; ++bj) { f32x4 v0 = acc[ai][bj][m][0], v1 = acc[ai][bj][m][1];
                    if (act) {
#pragma unroll
                        for (int j = 0; j < 4; ++j) { v0[j] = gelu_tanh(v0[j]); v1[j] = gelu_tanh(v1[j]); } }
                    u32x4 w; w.x = cvt_pk_bf16(v0[0], v0[1]); w.y = cvt_pk_bf16(v0[2], v0[3]); w.z = cvt_pk_bf16(v1[0], v1[1]); w.w = cvt_pk_bf16(v1[2], v1[3]);
                    *(u32x4*)(rowp + bj * HALF) = w; } }
    }
};
struct EpiF32 {
    static constexpr bool PERM = false, AFTER_DRAIN = false;
    float* C; int ldc; const float* bias; float* Cpart;
    __device__ __forceinline__ void operator()(const f32x4 (&acc)[2][2][4][2], const Unit& u, int wr, int wc, int fr, int fq) const {
        const int row0 = u.pm * BM + wr * 64 + fr, col0 = u.pn * BM + wc * 32 + 4 * fq;
        float* Cb = u.ks < 0 ? C : Cpart + (ptrdiff_t)(u.ks * 1024 - 32 * BM) * ldc;
        f32x4 bv[2][2];
#pragma unroll
        for (int bj = 0; bj < 2; ++bj)
#pragma unroll
            for (int n = 0; n < 2; ++n) bv[bj][n] = bias ? *(const f32x4*)(bias + col0 + bj * HALF + n * 16) : (f32x4){0.f, 0.f, 0.f, 0.f};
#pragma unroll
        for (int ai = 0; ai < 2; ++ai)
#pragma unroll
            for (int m = 0; m < 4; ++m) { float* rowp = Cb + (size_t)(row0 + ai * HALF + m * 16) * ldc + col0;
#pragma unroll
                for (int bj = 0; bj < 2; ++bj)
#pragma unroll
                    for (int n = 0; n < 2; ++n) *(f32x4*)(rowp + bj * HALF + n * 16) = acc[ai][bj][m][n] + bv[bj][n]; }
    }
};
template <class Epi, class Sched, bool ALIGN_EPI = false, bool SP2 = false>
__device__ __forceinline__ void gemm_phase(PG8_LAS unsigned char* lds, const Gemm g, const Sched& S, const Epi& E) {
    int tid_ = threadIdx.x; asm volatile("" : "+v"(tid_));
    const int tid = tid_, wid = __builtin_amdgcn_readfirstlane(tid >> 6), lane = tid & 63, wr = wid >> 2, wc = wid & 3, fr = lane & 15, fq = lane >> 4;
    const int K = g.K;
    unsigned voffA[2], voffB[2];
#pragma unroll
    for (int i = 0; i < 2; ++i) { int R, C; stage_rc(tid * 16 + i * 8192, R, C); const int Rb = Epi::PERM ? ((R & ~31) + perm32(R & 31)) : R;
        voffA[i] = (unsigned)(R * K + C) * 2u; voffB[i] = (unsigned)(Rb * K + C) * 2u; }
    const size_t kstep = (size_t)(BK * 2);
    const size_t hstep = (size_t)HALF * K * 2;
    const size_t tstep = 2 * hstep;
    const unsigned ldsw = (unsigned)wid * 1024u;
    const int aoff = lds_byte(wr * 64 + fr, fq * 8), boff = lds_byte(wc * 32 + fr, fq * 8);
#define PG8_SA(b, h) (((b) * 2 + (h)) * HTB)
#define PG8_SB(b, h) ((4 + (b) * 2 + (h)) * HTB)
#define PG8_STAGE(bufoff, gbase, voff) do { _Pragma("unroll") for (int _i = 0; _i < 2; ++_i) \
        __builtin_amdgcn_global_load_lds((const unsigned*)((const char*)(gbase) + (voff)[_i]), (PG8_LAS unsigned*)(lds + (bufoff) + ldsw + _i * 8192), 16, 0, 0); } while (0)
#define PG8_LDA(dst, b, h) do { _Pragma("unroll") for (int m = 0; m < 4; ++m) _Pragma("unroll") for (int k = 0; k < 2; ++k) dst[m][k] = *(const PG8_LAS bf16x8*)(lds + PG8_SA(b, h) + aoff + m * 2048 + k * 1024); } while (0)
#define PG8_LDB(dst, b, h) do { _Pragma("unroll") for (int n = 0; n < 2; ++n) _Pragma("unroll") for (int k = 0; k < 2; ++k) dst[n][k] = *(const PG8_LAS bf16x8*)(lds + PG8_SB(b, h) + boff + n * 2048 + k * 1024); } while (0)
#define PG8_MMA(ai, bj, At, Bt) do { __builtin_amdgcn_s_setprio(1); _Pragma("unroll") for (int m = 0; m < 4; ++m) _Pragma("unroll") for (int n = 0; n < 2; ++n) _Pragma("unroll") for (int k = 0; k < 2; ++k) \
        acc[ai][bj][m][n] = __builtin_amdgcn_mfma_f32_16x16x32_bf16(Bt[n][k], At[m][k], acc[ai][bj][m][n], 0, 0, 0); __builtin_amdgcn_s_setprio(0); } while (0)
#define PG8_WAIT_V(n) asm volatile("s_waitcnt vmcnt(" #n ")" ::: "memory")
#define PG8_WAIT_L(n) asm volatile("s_waitcnt lgkmcnt(" #n ")" ::: "memory")
#define PG8_BAR __builtin_amdgcn_s_barrier()
#define PG8_SCHED __builtin_amdgcn_sched_barrier(0)
    Unit cur, nxt; int ui = 0;
    if (!S.next(0, cur)) return;
    f32x4 acc[2][2][4][2];
#pragma unroll
    for (int a = 0; a < 2; ++a)
#pragma unroll
        for (int b = 0; b < 2; ++b)
#pragma unroll
            for (int m = 0; m < 4; ++m)
#pragma unroll
                for (int n = 0; n < 2; ++n) acc[a][b][m][n] = (f32x4){0.f, 0.f, 0.f, 0.f};
    bf16x8 At[4][2], B0[2][2], B1[2][2];
    const char* cA = (const char*)g.A + (size_t)cur.pm * tstep + (size_t)S.k0(cur) * 2; const char* cB = (const char*)g.Bt + (size_t)cur.pn * tstep + (size_t)S.k0(cur) * 2;
    S.a_ready(cur);
    if constexpr (SP2) {
        PG8_STAGE(PG8_SB(0, 0), cB, voffB); PG8_STAGE(PG8_SB(0, 1), cB + hstep, voffB); PG8_STAGE(PG8_SA(0, 0), cA, voffA); PG8_STAGE(PG8_SA(0, 1), cA + hstep, voffA);
        if (wr == 1) PG8_BAR;
        PG8_WAIT_V(2); PG8_BAR;
        PG8_STAGE(PG8_SB(1, 0), cB + kstep, voffB); PG8_STAGE(PG8_SA(1, 0), cA + kstep, voffA); PG8_STAGE(PG8_SB(1, 1), cB + hstep + kstep, voffB);
        PG8_WAIT_V(6); PG8_BAR;
    } else {
        PG8_STAGE(PG8_SB(0, 0), cB, voffB); PG8_STAGE(PG8_SA(0, 0), cA, voffA); PG8_STAGE(PG8_SB(0, 1), cB + hstep, voffB); PG8_STAGE(PG8_SA(0, 1), cA + hstep, voffA);
        if (wr == 1) PG8_BAR;
        PG8_WAIT_V(4); PG8_BAR;
        PG8_STAGE(PG8_SB(1, 0), cB + kstep, voffB); PG8_STAGE(PG8_SA(1, 0), cA + kstep, voffA); PG8_STAGE(PG8_SB(1, 1), cB + hstep + kstep, voffB);
        PG8_WAIT_V(6); PG8_BAR;
    }
    for (;;) {
        const bool has_next = S.next(ui + 1, nxt);
        const char* nA = has_next ? (const char*)g.A + (size_t)nxt.pm * tstep + (size_t)S.k0(nxt) * 2 : cA; const char* nB = has_next ? (const char*)g.Bt + (size_t)nxt.pn * tstep + (size_t)S.k0(nxt) * 2 : cB;
        const int nt = S.nt(cur);
        for (int t = 0; t < nt; t += 2) {
            const bool last = (t == nt - 2);
            const char* a1 = cA + (size_t)(t + 1) * kstep;
            const char* a2 = last ? nA : cA + (size_t)(t + 2) * kstep; const char* b2 = last ? nB : cB + (size_t)(t + 2) * kstep;
            const char* a3 = a2 + kstep; const char* b3 = b2 + kstep;
            if (last && has_next) S.a_ready(nxt);
            if constexpr (SP2) {
            PG8_LDB(B0, 0, 0); PG8_LDB(B1, 0, 1); PG8_SCHED; PG8_LDA(At, 0, 0); PG8_STAGE(PG8_SA(1, 1), a1 + hstep, voffA);
            PG8_WAIT_V(8); PG8_WAIT_L(0); PG8_BAR; PG8_MMA(0, 0, At, B0); PG8_MMA(0, 1, At, B1); PG8_BAR; PG8_SCHED;
            PG8_LDA(At, 0, 1); PG8_STAGE(PG8_SB(0, 0), b2, voffB); PG8_STAGE(PG8_SB(0, 1), b2 + hstep, voffB); PG8_STAGE(PG8_SA(0, 0), a2, voffA);
            PG8_WAIT_V(8); PG8_WAIT_L(0); PG8_BAR; PG8_MMA(1, 0, At, B0); PG8_MMA(1, 1, At, B1); PG8_BAR; PG8_SCHED;
            PG8_LDB(B0, 1, 0); PG8_LDB(B1, 1, 1); PG8_SCHED; PG8_LDA(At, 1, 0); PG8_STAGE(PG8_SA(0, 1), a2 + hstep, voffA);
            PG8_WAIT_V(8); PG8_WAIT_L(0); PG8_BAR; PG8_MMA(0, 0, At, B0); PG8_MMA(0, 1, At, B1); PG8_BAR; PG8_SCHED;
            PG8_LDA(At, 1, 1); PG8_STAGE(PG8_SB(1, 0), b3, voffB); PG8_STAGE(PG8_SB(1, 1), b3 + hstep, voffB); PG8_STAGE(PG8_SA(1, 0), a3, voffA);
            PG8_WAIT_V(8); PG8_WAIT_L(0); PG8_BAR; PG8_MMA(1, 0, At, B0); PG8_MMA(1, 1, At, B1); PG8_BAR; PG8_SCHED;
            } else {
            PG8_LDB(B0, 0, 0); PG8_SCHED; PG8_LDA(At, 0, 0); PG8_STAGE(PG8_SA(1, 1), a1 + hstep, voffA);
            PG8_WAIT_L(8); PG8_BAR; PG8_WAIT_L(0); PG8_MMA(0, 0, At, B0); PG8_BAR; PG8_SCHED;
            PG8_LDB(B1, 0, 1); PG8_STAGE(PG8_SB(0, 0), b2, voffB);
            PG8_BAR; PG8_WAIT_L(0); PG8_MMA(0, 1, At, B1); PG8_BAR;
            PG8_LDA(At, 0, 1); PG8_STAGE(PG8_SA(0, 0), a2, voffA);
            PG8_BAR; PG8_WAIT_L(0); PG8_MMA(1, 0, At, B0); PG8_BAR; PG8_SCHED;
            PG8_STAGE(PG8_SB(0, 1), b2 + hstep, voffB);
            PG8_WAIT_V(6); PG8_BAR; PG8_MMA(1, 1, At, B1); PG8_BAR;
            PG8_LDB(B0, 1, 0); PG8_SCHED; PG8_LDA(At, 1, 0); PG8_STAGE(PG8_SA(0, 1), a2 + hstep, voffA);
            PG8_WAIT_L(8); PG8_BAR; PG8_WAIT_L(0); PG8_MMA(0, 0, At, B0); PG8_BAR; PG8_SCHED;
            PG8_LDB(B1, 1, 1); PG8_STAGE(PG8_SB(1, 0), b3, voffB);
            PG8_BAR; PG8_WAIT_L(0); PG8_MMA(0, 1, At, B1); PG8_BAR;
            PG8_LDA(At, 1, 1); PG8_STAGE(PG8_SA(1, 0), a3, voffA);
            PG8_BAR; PG8_WAIT_L(0); PG8_MMA(1, 0, At, B0); PG8_BAR; PG8_SCHED;
            PG8_STAGE(PG8_SB(1, 1), b3 + hstep, voffB);
            PG8_WAIT_V(6); PG8_BAR; PG8_MMA(1, 1, At, B1); PG8_BAR;
            }
        }
        if constexpr (ALIGN_EPI) { if (wr == 0) PG8_BAR; }
        if constexpr (!Epi::AFTER_DRAIN) { E(acc, cur, wr, wc, fr, fq); S.done(cur); }
        if (!has_next) break;
#pragma unroll
        for (int a = 0; a < 2; ++a)
#pragma unroll
            for (int b = 0; b < 2; ++b)
#pragma unroll
                for (int m = 0; m < 4; ++m)
#pragma unroll
                    for (int n = 0; n < 2; ++n) acc[a][b][m][n] = (f32x4){0.f, 0.f, 0.f, 0.f};
        cur = nxt; cA = nA; cB = nB; ++ui;
        if constexpr (ALIGN_EPI) { if (wr == 1) PG8_BAR; }
    }
    PG8_WAIT_V(0);
    if constexpr (!ALIGN_EPI) { if (wr == 0) PG8_BAR; }
    PG8_BAR;
    if constexpr (Epi::AFTER_DRAIN) { E.fused(acc, cur, wr, wc, fr, fq, lds, wid, lane); S.done(cur); }
#undef PG8_SA
#undef PG8_SB
#undef PG8_STAGE
#undef PG8_LDA
#undef PG8_LDB
#undef PG8_MMA
#undef PG8_WAIT_V
#undef PG8_WAIT_L
#undef PG8_BAR
#undef PG8_SCHED
}
}

constexpr int DM = 2048, NP = 4, TP = 2048, NL = 4, NS = 128, TS = 8;
constexpr int MP = NP * TP, MS = NS * TS, M = MP + MS;
constexpr int WA = 1024, WB = 1024, INC = 5120, FF = 5632, FF2 = 2 * FF, NMOD = 6 * DM, NMODALL = NL * NMOD;
constexpr int NSEQ = NP + NS;
constexpr float EPS = 1e-6f;
constexpr size_t O_YP = 0, O_YS = O_YP + (size_t)MP * DM, O_MIXP = O_YS + (size_t)MS * DM, O_MIXS = O_MIXP + (size_t)NP * NL * 2 * WB,
                 O_FFNP = O_MIXS + (size_t)NS * NL * 2 * WB, O_FFNS = O_FFNP + (size_t)NP * NL * 2 * FF2, O_CVP = O_FFNS + (size_t)NS * NL * 2 * FF2,
                 O_CVS = O_CVP + (size_t)NP * NL * 128 * WA, O_END = O_CVS + (size_t)NS * NL * TS * WA;
static_assert(O_END == 38141952, "output size");
constexpr size_t MiB = 1u << 20;
constexpr size_t WS_CTL = 0, CTL_ZERO_BYTES = 1 * MiB;
constexpr size_t WS_SC = 1 * MiB;
constexpr size_t WS_MOD = 2 * MiB;
constexpr size_t WS_WIN = 50 * MiB, WS_WOUT = 130 * MiB, WS_WUP = 162 * MiB, WS_WDN = 338 * MiB, WS_WADA = 426 * MiB;
constexpr size_t WS_X = 618 * MiB, WS_H = 690 * MiB, WS_PROJ = 726 * MiB, WS_MRG = 816 * MiB, WS_Y = 852 * MiB, WS_UP = 924 * MiB, WS_ACT = 1122 * MiB, WS_PART = 1221 * MiB, WS_END = 1285 * MiB;
static_assert(WS_MOD + (size_t)256 * NMODALL * 4 <= WS_WIN && WS_WIN + (size_t)NL * INC * DM * 2 <= WS_WOUT && WS_WOUT + (size_t)NL * DM * DM * 2 <= WS_WUP &&
              WS_WUP + (size_t)NL * FF2 * DM * 2 <= WS_WDN && WS_WDN + (size_t)NL * DM * FF * 2 <= WS_WADA && WS_WADA + (size_t)NMODALL * DM * 2 <= WS_X &&
              WS_X + (size_t)M * DM * 4 <= WS_H && WS_H + (size_t)M * DM * 2 <= WS_PROJ && WS_PROJ + (size_t)M * INC * 2 <= WS_MRG && WS_MRG + (size_t)M * DM * 2 <= WS_Y &&
              WS_Y + (size_t)M * DM * 4 <= WS_UP && WS_UP + (size_t)M * FF2 * 2 <= WS_ACT && WS_ACT + (size_t)M * FF * 2 <= WS_PART && WS_PART + (size_t)8 * MS * DM * 4 <= WS_END, "d_ws map");
constexpr int CW_BAR = 4096;
constexpr int RING_BYTES = 131072;
constexpr int MISC_OFF = RING_BYTES;
constexpr int TAB_OFF = RING_BYTES + 1024;
constexpr int LDS_BYTES = 147456;
constexpr int NWAVES = 8, NTHREADS = 512;
constexpr int NPHASES = 3 + 8 * NL;

#define GAS __attribute__((address_space(1)))
#define LAS __attribute__((address_space(3)))
typedef unsigned short bf16;
typedef unsigned v4u __attribute__((ext_vector_type(4)));
typedef unsigned v2u __attribute__((ext_vector_type(2)));
typedef float f32x4 __attribute__((ext_vector_type(4)));
typedef short bf16x8 __attribute__((ext_vector_type(8)));
typedef short s16x4 __attribute__((ext_vector_type(4)));
typedef GAS unsigned gu32;
#define RLX_AGENT __ATOMIC_RELAXED, __HIP_MEMORY_SCOPE_AGENT
#define LDS_WAIT() asm volatile("s_waitcnt lgkmcnt(0)" ::: "memory")
#define VM_WAIT() asm volatile("s_waitcnt vmcnt(0)" ::: "memory")
__device__ __forceinline__ unsigned pk2(float lo, float hi) { return pg8::cvt_pk_bf16(lo, hi); }
__device__ __forceinline__ float bflo(unsigned w) { return __builtin_bit_cast(float, w << 16); }
__device__ __forceinline__ float bfhi(unsigned w) { return __builtin_bit_cast(float, w & 0xffff0000u); }
__device__ __forceinline__ void unpack8(const v4u w, float (&f)[8]) { f[0] = bflo(w.x); f[1] = bfhi(w.x); f[2] = bflo(w.y); f[3] = bfhi(w.y); f[4] = bflo(w.z); f[5] = bfhi(w.z); f[6] = bflo(w.w); f[7] = bfhi(w.w); }
__device__ __forceinline__ v4u pack8(const float (&f)[8]) { v4u w; w.x = pk2(f[0], f[1]); w.y = pk2(f[2], f[3]); w.z = pk2(f[4], f[5]); w.w = pk2(f[6], f[7]); return w; }
__device__ __forceinline__ float wave_sum(float v) {
#pragma unroll
    for (int o = 1; o < 64; o <<= 1) v += __shfl_xor(v, o);
    return v;
}
__device__ __forceinline__ float silu_f(float x) { return x * __builtin_amdgcn_rcpf(1.0f + __builtin_amdgcn_exp2f(-1.4426950409f * x)); }

#define XB_TMO      128
#define XB_XCNT(j)  (256  + 64 * (j))
#define XB_XSUB(j)  (1280 + 64 * (j))
#define XB_XGEN(j)  (2304 + 64 * (j))
#define XB_TOP      3328
#define XB_TOPGEN   3392
#define XCD_BAR_WORDS 3456
#define XB_SPIN_CAP (1u << 18)

__device__ __forceinline__ unsigned xb_ld(unsigned* p)              { return __hip_atomic_load(p, __ATOMIC_RELAXED, __HIP_MEMORY_SCOPE_AGENT); }
__device__ __forceinline__ unsigned xb_add(unsigned* p, unsigned v) { return __hip_atomic_fetch_add(p, v, __ATOMIC_RELAXED, __HIP_MEMORY_SCOPE_AGENT); }
__device__ __forceinline__ unsigned xb_xcc_id() { return (unsigned)__builtin_amdgcn_s_getreg((3 << 11) | 20) & 0xFu; }
#define XB_SPIN(cond, bar) do { unsigned _sp = 0; while (cond) { __builtin_amdgcn_s_sleep(1); \
    if ((++_sp & 255u) == 0u) { if (xb_ld(&(bar)[XB_TMO])) break; if (_sp > XB_SPIN_CAP) { atomicAdd(&(bar)[XB_TMO], 1u); break; } } } } while (0)

struct XcdBarrier {
    unsigned* bar; unsigned x;
    volatile LAS unsigned* st;
};

__device__ __forceinline__ XcdBarrier xcd_barrier_post(unsigned* bar, volatile LAS unsigned* st) {
    XcdBarrier b; b.bar = bar; b.x = xb_xcc_id(); b.st = st;
    if (threadIdx.x == 0) (void)xb_add(&bar[XB_XCNT(b.x)], 1u);
    return b;
}
__device__ __forceinline__ void xcd_barrier_complete(unsigned* bar, unsigned x, unsigned& nloc, unsigned& nx) {
    const unsigned G = gridDim.x * gridDim.y * gridDim.z;
    unsigned sum, cnt, mine, sp = 0u;
    for (;;) {
        sum = 0u; cnt = 0u; mine = 0u;
#pragma unroll
        for (unsigned j = 0; j < 16; ++j) { const unsigned c = xb_ld(&bar[XB_XCNT(j)]); sum += c; cnt += (c > 0u) ? 1u : 0u; mine = (j == x) ? c : mine; }
        if (sum == G) break;
        __builtin_amdgcn_s_sleep(1);
        if ((++sp & 255u) == 0u) { if (xb_ld(&bar[XB_TMO])) break; if (sp > XB_SPIN_CAP) { atomicAdd(&bar[XB_TMO], 1u); break; } }
    }
    nloc = mine > 0u ? mine : 1u; nx = cnt > 0u ? cnt : 1u;
}

__device__ __forceinline__ void xcd_barrier(const XcdBarrier& b) {
    asm volatile("s_waitcnt vmcnt(0)" ::: "memory");
    __syncthreads();
    if (threadIdx.x == 0) {
        unsigned* bar = b.bar;
        __builtin_amdgcn_s_waitcnt(0);
        unsigned nloc = b.st[0], nx = b.st[1];
        if (nloc == 0u) { xcd_barrier_complete(bar, b.x, nloc, nx); b.st[0] = nloc; b.st[1] = nx; }
        const unsigned old = xb_add(&bar[XB_XSUB(b.x)], 1u);
        const unsigned gen = old / nloc;
        if (old + 1u == (gen + 1u) * nloc) {
            __builtin_amdgcn_fence(__ATOMIC_RELEASE, "agent");
            asm volatile("s_waitcnt vmcnt(0)" ::: "memory");
            const unsigned og = xb_add(&bar[XB_TOP], 1u);
            const unsigned tg = og / nx;
            if (og + 1u == (tg + 1u) * nx) xb_add(&bar[XB_TOPGEN], 1u);
            else XB_SPIN(xb_ld(&bar[XB_TOPGEN]) == tg, bar);
            __builtin_amdgcn_fence(__ATOMIC_ACQUIRE, "agent");
            xb_add(&bar[XB_XGEN(b.x)], 1u);
            asm volatile("s_waitcnt vmcnt(0)" ::: "memory");
        } else {
            XB_SPIN(xb_ld(&bar[XB_XGEN(b.x)]) == gen, bar);
            __builtin_amdgcn_fence(__ATOMIC_ACQUIRE, "agent");
            asm volatile("s_waitcnt vmcnt(0)" ::: "memory");
        }
    }
    __syncthreads();
}


struct Ctx {
    LAS unsigned char* lds;
    int tid, lane, wave, G, bid;
};
__device__ __forceinline__ unsigned long long karg_u64(int byte_off) {
    unsigned long long p; const unsigned long long ka = (unsigned long long)__builtin_amdgcn_kernarg_segment_ptr();
    asm volatile("s_load_dwordx2 %0, %1, %2\n\ts_waitcnt lgkmcnt(0)" : "=s"(p) : "s"(ka), "i"(byte_off) : "memory");
    return p;
}
__device__ __forceinline__ const float* karg(int k) { return (const float*)(const GAS float*)karg_u64(8 * k); }
__device__ __forceinline__ unsigned char* kws() { return (unsigned char*)(GAS unsigned char*)karg_u64(200); }
__device__ __forceinline__ float* kout() { return (float*)(GAS float*)karg_u64(192); }
__device__ __forceinline__ int opqv(int v) { asm volatile("" : "+v"(v)); return v; }
__device__ __forceinline__ int seq_of(int m) { return m < MP ? (m >> 11) : NP + ((m - MP) >> 3); }

__device__ __forceinline__ void p0_transpose_item(const float* W, int K, int N, bf16* WT, int item, int lane) {
    const int nblk = N >> 8, kb = item / nblk, nb = item - kb * nblk;
    const float* src = W + (size_t)(64 * kb) * N + 256 * nb + 4 * lane;
    bf16* dst = WT + (size_t)(256 * nb + 4 * lane) * K + 64 * kb;
#pragma unroll 2
    for (int ks = 0; ks < 8; ++ks) {
        f32x4 v[8];
#pragma unroll
        for (int kk = 0; kk < 8; ++kk) v[kk] = __builtin_nontemporal_load((const f32x4*)(src + (size_t)(8 * ks + kk) * N));
#pragma unroll
        for (int i = 0; i < 4; ++i) { v4u o; o.x = pk2(v[0][i], v[1][i]); o.y = pk2(v[2][i], v[3][i]); o.z = pk2(v[4][i], v[5][i]); o.w = pk2(v[6][i], v[7][i]);
            *(v4u*)(dst + (size_t)i * K + 8 * ks) = o; }
    }
}
__device__ __forceinline__ void p0a_prologue(Ctx& F) {
    unsigned char* const ws = kws();
    const int lane = opqv(F.lane);
    const int gw = F.bid * NWAVES + F.wave, NGW = F.G * NWAVES;
    constexpr int I_IN = (DM / 64) * (INC / 256), I_OUT = (DM / 64) * (DM / 256), I_UP = (DM / 64) * (FF2 / 256), I_DN = (FF / 64) * (DM / 256), I_ADA = (DM / 64) * (NMOD / 256);
    constexpr int I_LAYER = I_IN + I_OUT + I_UP + I_DN + I_ADA;
    for (int it = gw; it < NL * I_LAYER; it += NGW) {
        const int l = it / I_LAYER; int r = it - l * I_LAYER;
        const float* W; bf16* WT; int K, N;
        if (r < I_IN)                      { W = karg(12) + (size_t)l * DM * INC;  WT = ((bf16*)(ws + WS_WIN))  + (size_t)l * INC * DM;  K = DM; N = INC; }
        else if ((r -= I_IN) < I_OUT)      { W = karg(19) + (size_t)l * DM * DM;   WT = ((bf16*)(ws + WS_WOUT)) + (size_t)l * DM * DM;   K = DM; N = DM; }
        else if ((r -= I_OUT) < I_UP)      { W = karg(20) + (size_t)l * DM * FF2;  WT = ((bf16*)(ws + WS_WUP))  + (size_t)l * FF2 * DM;  K = DM; N = FF2; }
        else if ((r -= I_UP) < I_DN)       { W = karg(23) + (size_t)l * FF * DM;   WT = ((bf16*)(ws + WS_WDN))  + (size_t)l * DM * FF;   K = FF; N = DM; }
        else { r -= I_DN;                    W = karg(6)  + (size_t)l * DM * NMOD; WT = ((bf16*)(ws + WS_WADA)) + (size_t)l * NMOD * DM; K = DM; N = NMOD; }
        p0_transpose_item(W, K, N, WT, r, lane);
    }
    for (int r = gw; r < 256; r += NGW) {
        v2u* o = (v2u*)(((bf16*)(ws + WS_SC)) + (size_t)r * DM) + lane;
        if (r < NSEQ) { const f32x4* c = (const f32x4*)(r < NP ? karg(4) + (size_t)r * DM : karg(5) + (size_t)(r - NP) * DM) + lane;
#pragma unroll
            for (int j = 0; j < 8; ++j) { const f32x4 v = c[64 * j]; v2u w; w.x = pk2(silu_f(v.x), silu_f(v.y)); w.y = pk2(silu_f(v.z), silu_f(v.w)); o[64 * j] = w; } }
        else {
#pragma unroll
            for (int j = 0; j < 8; ++j) o[64 * j] = (v2u){0u, 0u}; }
    }
}
__device__ __forceinline__ const float* x_in_row(const Ctx& F, int m) { return m < MP ? karg(0) + (size_t)m * DM : karg(1) + (size_t)(m - MP) * DM; }
__device__ __forceinline__ void norm_mod_store(const f32x4 (&x)[8], const float* g, const float* sc, const float* sh, bf16* hrow, int lane) {
    float ss = 0.f;
#pragma unroll
    for (int j = 0; j < 8; ++j) ss += (x[j].x * x[j].x + x[j].y * x[j].y) + (x[j].z * x[j].z + x[j].w * x[j].w);
    const float rs = __builtin_amdgcn_rsqf(wave_sum(ss) * (1.0f / DM) + EPS);
    v2u* o = (v2u*)hrow + lane;
#pragma unroll
    for (int j = 0; j < 8; ++j) { const f32x4 gv = ((const f32x4*)g)[lane + 64 * j], sv = ((const f32x4*)sc)[lane + 64 * j], hv = ((const f32x4*)sh)[lane + 64 * j];
        const f32x4 h = x[j] * rs * gv * (sv + 1.0f) + hv; v2u w; w.x = pk2(h.x, h.y); w.y = pk2(h.z, h.w); o[64 * j] = w; }
}
__device__ __forceinline__ void p0c_h0(Ctx& F) {
    unsigned char* const ws = kws();
    const int lane = opqv(F.lane);
    const int gw = F.bid * NWAVES + F.wave, NGW = F.G * NWAVES;
    for (int m = gw; m < M; m += NGW) {
        const float* mod = ((float*)(ws + WS_MOD)) + (size_t)seq_of(m) * NMODALL;
        const f32x4* xr = (const f32x4*)x_in_row(F, m) + lane; f32x4 x[8];
#pragma unroll
        for (int j = 0; j < 8; ++j) x[j] = xr[64 * j];
        norm_mod_store(x, karg(8), mod + DM, mod, ((bf16*)(ws + WS_H)) + (size_t)m * DM, lane);
    }
}
template <bool MID> __device__ __forceinline__ void row_update(Ctx& F, int l) {
    unsigned char* const ws = kws();
    float* const out = kout();
    const int lane = opqv(F.lane);
    const int gw = F.bid * NWAVES + F.wave, NGW = F.G * NWAVES;
    const bool fin = !MID && (l == NL - 1);
    const float* gpost = (MID ? karg(9) : karg(11)) + (size_t)l * DM;
    const float* gpre = MID ? karg(10) + (size_t)l * DM : karg(8) + (size_t)(l + 1 < NL ? l + 1 : l) * DM;
    for (int m = gw; m < M; m += NGW) {
        const float* mod = ((float*)(ws + WS_MOD)) + (size_t)seq_of(m) * NMODALL + (size_t)l * NMOD;
        const float* gt = mod + (MID ? 2 : 5) * DM;
        const float* sc = MID ? mod + 4 * DM : mod + NMOD + DM;
        const float* sh = MID ? mod + 3 * DM : mod + NMOD;
        const f32x4* yr = (const f32x4*)(((float*)(ws + WS_Y)) + (size_t)m * DM) + lane;
        const f32x4* xr = (const f32x4*)((MID && l == 0) ? x_in_row(F, m) : ((float*)(ws + WS_X)) + (size_t)m * DM) + lane;
        f32x4 y[8], x[8]; float ss = 0.f;
#pragma unroll
        for (int j = 0; j < 8; ++j) { y[j] = yr[64 * j]; x[j] = xr[64 * j]; }
        if (m >= MP) {
            const f32x4* pr = (const f32x4*)(((float*)(ws + WS_PART)) + (size_t)(m - MP) * DM) + lane;
#pragma unroll
            for (int j = 0; j < 8; ++j) y[j] = pr[64 * j];
#pragma unroll 1
            for (int ks = 1; ks < 8; ++ks) {
#pragma unroll
                for (int j = 0; j < 8; ++j) y[j] = y[j] + pr[(size_t)ks * (MS * DM / 4) + 64 * j]; }
        }
#pragma unroll
        for (int j = 0; j < 8; ++j) ss += (y[j].x * y[j].x + y[j].y * y[j].y) + (y[j].z * y[j].z + y[j].w * y[j].w);
        const float rs = __builtin_amdgcn_rsqf(wave_sum(ss) * (1.0f / DM) + EPS);
#pragma unroll
        for (int j = 0; j < 8; ++j) { const f32x4 gp = ((const f32x4*)gpost)[lane + 64 * j], gv = ((const f32x4*)gt)[lane + 64 * j]; x[j] = x[j] + gv * (y[j] * rs * gp); }
        if (fin) { f32x4* o = (f32x4*)(out + (size_t)m * DM) + lane;
#pragma unroll
            for (int j = 0; j < 8; ++j) o[64 * j] = x[j]; }
        else { f32x4* o = (f32x4*)(((float*)(ws + WS_X)) + (size_t)m * DM) + lane;
#pragma unroll
            for (int j = 0; j < 8; ++j) o[64 * j] = x[j];
            norm_mod_store(x, gpre, sc, sh, ((bf16*)(ws + WS_H)) + (size_t)m * DM, lane); }
    }
}
__device__ __forceinline__ s16x4 lds_tr16(LAS unsigned char* p) { return __builtin_bit_cast(s16x4, __builtin_amdgcn_ds_read_tr16_b64_v4i16((LAS s16x4*)p)); }
__device__ __forceinline__ void mixer_a_unit(Ctx& F, int l, int u) {
    unsigned char* const ws = kws();
    float* const out = kout();
    const int lane = opqv(F.lane), h = F.wave;
    const bool samp = u >= 64;
    const int bsel = u >> 4, ci = u & 15;
    const int m0 = samp ? MP + (u - 64) * 128 : bsel * TP + ci * 128;
    const bf16* P = ((bf16*)(ws + WS_PROJ)) + (size_t)m0 * INC;
    LAS float* R = (LAS float*)(F.lds + TAB_OFF);
    LAS float* SSQ = R + 128;
    __syncthreads();
    {
        const float* gv = karg(13) + (size_t)l * WA;
        const bool wr_rows = samp || ci == 15;
        for (int i = 0; i < 16; ++i) {
            const int s = 16 * h + i;
            const bf16* vr = P + (size_t)s * INC + WA;
            const v4u a = *(const v4u*)(vr + 8 * lane), b = *(const v4u*)(vr + 512 + 8 * lane);
            float fa[8], fb[8]; unpack8(a, fa); unpack8(b, fb);
            float ss = 0.f;
#pragma unroll
            for (int j = 0; j < 8; ++j) ss += fa[j] * fa[j] + fb[j] * fb[j];
            const float r = __builtin_amdgcn_rsqf(wave_sum(ss) * (1.0f / WA) + EPS);
            if (lane == 0) R[s] = r;
            if (wr_rows) {
                float* o = samp ? out + O_CVS + ((size_t)(((u - 64) * 16 + (s >> 3)) * NL + l) * TS + (s & 7)) * WA
                                : out + O_CVP + ((size_t)(bsel * NL + l) * 128 + s) * WA;
                const f32x4 g0 = *(const f32x4*)(gv + 8 * lane), g1 = *(const f32x4*)(gv + 8 * lane + 4), g2 = *(const f32x4*)(gv + 512 + 8 * lane), g3 = *(const f32x4*)(gv + 512 + 8 * lane + 4);
                *(f32x4*)(o + 8 * lane) = (f32x4){fa[0], fa[1], fa[2], fa[3]} * r * g0; *(f32x4*)(o + 8 * lane + 4) = (f32x4){fa[4], fa[5], fa[6], fa[7]} * r * g1;
                *(f32x4*)(o + 512 + 8 * lane) = (f32x4){fb[0], fb[1], fb[2], fb[3]} * r * g2; *(f32x4*)(o + 512 + 8 * lane + 4) = (f32x4){fb[4], fb[5], fb[6], fb[7]} * r * g3;
            }
        }
    }
    __syncthreads();
    LAS unsigned char* vt = F.lds + h * 16384;
    const float* Wsp = karg(14) + ((size_t)l * 8 + h) * 128 * 128;
    const float* bsp = karg(15) + (size_t)(l * 8 + h) * 128;
    const float* gvh = karg(13) + (size_t)l * WA + 128 * h;
    const float* gah = karg(17) + (size_t)l * WA + 128 * h;
    const int g = lane >> 4, i16 = lane & 15, q = i16 >> 2, p = i16 & 3;
#pragma unroll 1
    for (int dh = 0; dh < 2; ++dh) {
#pragma unroll
        for (int it = 0; it < 16; ++it) { const int s = it * 8 + (lane >> 3);
            const v4u x = *(const v4u*)(P + (size_t)s * INC + WA + 128 * h + 64 * dh + 8 * (lane & 7));
            *(LAS v4u*)(vt + s * 128 + (lane & 7) * 16) = x; }
        LDS_WAIT(); asm volatile("" ::: "memory");
        bf16x8 vf[4][4];
#pragma unroll
        for (int ks = 0; ks < 4; ++ks)
#pragma unroll
            for (int nt = 0; nt < 4; ++nt) { LAS unsigned char* a = vt + (32 * ks + 8 * g + q) * 128 + (16 * nt + 4 * p) * 2;
                const s16x4 lo = lds_tr16(a), hi = lds_tr16(a + 4 * 128);
                vf[ks][nt] = (bf16x8){lo[0], lo[1], lo[2], lo[3], hi[0], hi[1], hi[2], hi[3]}; }
#pragma unroll 1
        for (int tm = 0; tm < 8; ++tm) {
            const int t = 16 * tm + i16;
            const int tl = samp ? (t & 7) : t;
            const int nks = (tm >> 1) + 1;
            f32x4 acc[4];
#pragma unroll
            for (int nt = 0; nt < 4; ++nt) acc[nt] = (f32x4){0.f, 0.f, 0.f, 0.f};
#pragma unroll
            for (int ks = 0; ks < 4; ++ks) {
                if (ks < nks) {
                    const int s0 = 32 * ks + 8 * g;
                    const int sl0 = samp ? 0 : s0;
                    const bool blk = samp ? ((s0 >> 3) == (t >> 3)) : true;
                    const float* wp = Wsp + (size_t)tl * 128 + sl0;
                    const f32x4 w0 = *(const f32x4*)wp, w1 = *(const f32x4*)(wp + 4);
                    float w[8] = {w0.x, w0.y, w0.z, w0.w, w1.x, w1.y, w1.z, w1.w};
                    const f32x4 r0 = *(const LAS f32x4*)(R + s0), r1 = *(const LAS f32x4*)(R + s0 + 4);
                    const float rr[8] = {r0.x, r0.y, r0.z, r0.w, r1.x, r1.y, r1.z, r1.w};
#pragma unroll
                    for (int j = 0; j < 8; ++j) w[j] = (blk && (sl0 + j <= tl)) ? w[j] * rr[j] : 0.f;
                    v4u ww; ww.x = pk2(w[0], w[1]); ww.y = pk2(w[2], w[3]); ww.z = pk2(w[4], w[5]); ww.w = pk2(w[6], w[7]);
                    const bf16x8 wf = __builtin_bit_cast(bf16x8, ww);
#pragma unroll
                    for (int nt = 0; nt < 4; ++nt) acc[nt] = __builtin_amdgcn_mfma_f32_16x16x32_bf16(vf[ks][nt], wf, acc[nt], 0, 0, 0);
                }
            }
            const float bias = bsp[tl];
            const size_t m = (size_t)m0 + t;
            float ss = 0.f;
#pragma unroll
            for (int nt = 0; nt < 4; ++nt) {
                const int d = 64 * dh + 16 * nt + 4 * g;
                const v2u uw = *(const v2u*)(P + (size_t)t * INC + 128 * h + d);
                const f32x4 uu = (f32x4){bflo(uw.x), bfhi(uw.x), bflo(uw.y), bfhi(uw.y)};
                const f32x4 gv4 = *(const f32x4*)(gvh + d), ga4 = *(const f32x4*)(gah + d);
                const f32x4 o = uu * (acc[nt] * gv4 + bias);
                ss += (o.x * o.x + o.y * o.y) + (o.z * o.z + o.w * o.w);
                const f32x4 og = o * ga4; v2u w2; w2.x = pk2(og.x, og.y); w2.y = pk2(og.z, og.w);
                *(v2u*)(((bf16*)(ws + WS_MRG)) + m * DM + 128 * h + d) = w2;
            }
            ss += __shfl_xor(ss, 16); ss += __shfl_xor(ss, 32);
            if (g == 0) SSQ[(t * 8 + h) * 2 + dh] = ss;
        }
        LDS_WAIT(); asm volatile("" ::: "memory");
    }
    __syncthreads();
    for (int i = 0; i < 16; ++i) {
        const int s = 16 * h + i;
        const LAS f32x4* qq = (const LAS f32x4*)(SSQ + s * 16); const f32x4 q0 = qq[0], q1 = qq[1], q2 = qq[2], q3 = qq[3];
        const float tot = (((q0.x + q0.y) + (q0.z + q0.w)) + ((q1.x + q1.y) + (q1.z + q1.w))) + (((q2.x + q2.y) + (q2.z + q2.w)) + ((q3.x + q3.y) + (q3.z + q3.w)));
        const float ra = __builtin_amdgcn_rsqf(tot * (1.0f / WA) + EPS);
        bf16* row = ((bf16*)(ws + WS_MRG)) + ((size_t)m0 + s) * DM;
        float fa[8], fb[8]; unpack8(*(const v4u*)(row + 8 * lane), fa); unpack8(*(const v4u*)(row + 512 + 8 * lane), fb);
#pragma unroll
        for (int j = 0; j < 8; ++j) { fa[j] *= ra; fb[j] *= ra; }
        *(v4u*)(row + 8 * lane) = pack8(fa); *(v4u*)(row + 512 + 8 * lane) = pack8(fb);
    }
}
__device__ __forceinline__ void load16f(const float* p, int lane, float (&f)[16]) {
    const f32x4 a = *(const f32x4*)(p + 8 * lane), b = *(const f32x4*)(p + 8 * lane + 4), c = *(const f32x4*)(p + 512 + 8 * lane), d = *(const f32x4*)(p + 512 + 8 * lane + 4);
    f[0] = a.x; f[1] = a.y; f[2] = a.z; f[3] = a.w; f[4] = b.x; f[5] = b.y; f[6] = b.z; f[7] = b.w; f[8] = c.x; f[9] = c.y; f[10] = c.z; f[11] = c.w; f[12] = d.x; f[13] = d.y; f[14] = d.z; f[15] = d.w;
}
__device__ __forceinline__ void load16b(const bf16* p, int lane, float (&f)[16]) {
    float a[8], b[8]; unpack8(*(const v4u*)(p + 8 * lane), a); unpack8(*(const v4u*)(p + 512 + 8 * lane), b);
#pragma unroll
    for (int j = 0; j < 8; ++j) { f[j] = a[j]; f[8 + j] = b[j]; }
}
__device__ __forceinline__ void store16f(float* p, int lane, const float (&f)[16]) {
    *(f32x4*)(p + 8 * lane) = (f32x4){f[0], f[1], f[2], f[3]}; *(f32x4*)(p + 8 * lane + 4) = (f32x4){f[4], f[5], f[6], f[7]};
    *(f32x4*)(p + 512 + 8 * lane) = (f32x4){f[8], f[9], f[10], f[11]}; *(f32x4*)(p + 512 + 8 * lane + 4) = (f32x4){f[12], f[13], f[14], f[15]};
}
__device__ __forceinline__ void mixer_b_item(Ctx& F, int l, int seg) {
    unsigned char* const ws = kws();
    float* const out = kout();
    const int lane = opqv(F.lane);
    const int m0 = seg * 8;
    const bool samp = m0 >= MP;
    const int b = samp ? (m0 - MP) >> 3 : m0 >> 11, t0 = samp ? 0 : (m0 & (TP - 1));
    float w0[16], w1[16], w2[16], gb[16], p2[16], p1[16];
    load16f(karg(16) + (size_t)l * 3 * WB, lane, w0); load16f(karg(16) + (size_t)l * 3 * WB + WB, lane, w1); load16f(karg(16) + (size_t)l * 3 * WB + 2 * WB, lane, w2);
    load16f(karg(18) + (size_t)l * WB, lane, gb);
    if (samp) { const float* st = karg(2) + (size_t)(b * NL + l) * 2 * WB; load16f(st, lane, p2); load16f(st + WB, lane, p1); }
    else if (t0 == 0) {
#pragma unroll
        for (int j = 0; j < 16; ++j) { p2[j] = 0.f; p1[j] = 0.f; } }
    else { float a[16], c[16];
        load16b(((bf16*)(ws + WS_PROJ)) + (size_t)(m0 - 2) * INC + 3072, lane, a); load16b(((bf16*)(ws + WS_PROJ)) + (size_t)(m0 - 2) * INC + 4096, lane, c);
#pragma unroll
        for (int j = 0; j < 16; ++j) p2[j] = a[j] * c[j];
        load16b(((bf16*)(ws + WS_PROJ)) + (size_t)(m0 - 1) * INC + 3072, lane, a); load16b(((bf16*)(ws + WS_PROJ)) + (size_t)(m0 - 1) * INC + 4096, lane, c);
#pragma unroll
        for (int j = 0; j < 16; ++j) p1[j] = a[j] * c[j]; }
    const bool tail = samp || (t0 + 8 == TP);
    float* omix = (samp ? out + O_MIXS : out + O_MIXP) + (size_t)(b * NL + l) * 2 * WB;
#pragma unroll
    for (int r = 0; r < 8; ++r) {
        const bf16* pr = ((bf16*)(ws + WS_PROJ)) + (size_t)(m0 + r) * INC;
        float gbv[16], gc[16], hb[16], cin[16], ob[16];
        load16b(pr + 2048, lane, gbv); load16b(pr + 3072, lane, gc); load16b(pr + 4096, lane, hb);
        float ss = 0.f;
#pragma unroll
        for (int j = 0; j < 16; ++j) { cin[j] = gc[j] * hb[j]; ob[j] = gbv[j] * (w0[j] * p2[j] + w1[j] * p1[j] + w2[j] * cin[j]); ss += ob[j] * ob[j]; }
        const float rb = __builtin_amdgcn_rsqf(wave_sum(ss) * (1.0f / WB) + EPS);
        float oa[8], oc[8];
#pragma unroll
        for (int j = 0; j < 8; ++j) { oa[j] = ob[j] * rb * gb[j]; oc[j] = ob[8 + j] * rb * gb[8 + j]; }
        bf16* mr = ((bf16*)(ws + WS_MRG)) + (size_t)(m0 + r) * DM + WA;
        *(v4u*)(mr + 8 * lane) = pack8(oa); *(v4u*)(mr + 512 + 8 * lane) = pack8(oc);
        if (tail && r >= 6) store16f(omix + (size_t)(r - 6) * WB, lane, cin);
#pragma unroll
        for (int j = 0; j < 16; ++j) { p2[j] = p1[j]; p1[j] = cin[j]; }
    }
}
__device__ __forceinline__ void p2_mixer(Ctx& F, int l) {
    constexpr int NA = 72, NBB = (M / 8) / NWAVES;
    for (int u = F.bid; u < NA + NBB; u += F.G) {
        if (u < NA) { MA(mixer_a_unit(F, l, u)); }
        else { MB(mixer_b_item(F, l, (u - NA) * NWAVES + F.wave)); }
    }
}
__device__ __forceinline__ void conv_ffn_item(Ctx& F, int l, int item) {
    unsigned char* const ws = kws();
    float* const out = kout();
    const int lane = opqv(F.lane);
    const int seg = item / 11, cc = item - seg * 11;
    const bool samp = seg >= 512;
    const int b = samp ? seg - 512 : seg >> 7, t0 = samp ? 0 : (seg & 127) * 16, nrows = samp ? 8 : 16;
    const int m0 = samp ? MP + b * 8 : seg * 16;
    const int jg = cc * 512 + 8 * lane, jv = FF + jg;
    const float* wc = karg(21) + (size_t)l * 3 * FF2; const float* bc = karg(22) + (size_t)l * FF2;
    float w0g[8], w1g[8], w2g[8], bg[8], w0v[8], w1v[8], w2v[8], bv[8], g2[8], g1[8], v2[8], v1[8];
#define LD8F(dst, ptr) do { const f32x4 _a = *(const f32x4*)(ptr), _b = *(const f32x4*)((ptr) + 4); dst[0] = _a.x; dst[1] = _a.y; dst[2] = _a.z; dst[3] = _a.w; dst[4] = _b.x; dst[5] = _b.y; dst[6] = _b.z; dst[7] = _b.w; } while (0)
    LD8F(w0g, wc + jg); LD8F(w1g, wc + FF2 + jg); LD8F(w2g, wc + 2 * FF2 + jg); LD8F(bg, bc + jg);
    LD8F(w0v, wc + jv); LD8F(w1v, wc + FF2 + jv); LD8F(w2v, wc + 2 * FF2 + jv); LD8F(bv, bc + jv);
    if (samp) { const float* st = karg(3) + (size_t)(b * NL + l) * 2 * FF2; LD8F(g2, st + jg); LD8F(v2, st + jv); LD8F(g1, st + FF2 + jg); LD8F(v1, st + FF2 + jv); }
    else if (t0 == 0) {
#pragma unroll
        for (int j = 0; j < 8; ++j) { g2[j] = 0.f; g1[j] = 0.f; v2[j] = 0.f; v1[j] = 0.f; } }
    else { unpack8(*(const v4u*)(((bf16*)(ws + WS_UP)) + (size_t)(m0 - 2) * FF2 + jg), g2); unpack8(*(const v4u*)(((bf16*)(ws + WS_UP)) + (size_t)(m0 - 2) * FF2 + jv), v2);
           unpack8(*(const v4u*)(((bf16*)(ws + WS_UP)) + (size_t)(m0 - 1) * FF2 + jg), g1); unpack8(*(const v4u*)(((bf16*)(ws + WS_UP)) + (size_t)(m0 - 1) * FF2 + jv), v1); }
    const bool tail = samp || (t0 + 16 == TP);
    float* offn = (samp ? out + O_FFNS : out + O_FFNP) + (size_t)(b * NL + l) * 2 * FF2;
#pragma unroll 8
    for (int r = 0; r < nrows; ++r) {
        float xg[8], xv[8], a[8];
        unpack8(*(const v4u*)(((bf16*)(ws + WS_UP)) + (size_t)(m0 + r) * FF2 + jg), xg); unpack8(*(const v4u*)(((bf16*)(ws + WS_UP)) + (size_t)(m0 + r) * FF2 + jv), xv);
#pragma unroll
        for (int j = 0; j < 8; ++j) { const float G = w0g[j] * g2[j] + w1g[j] * g1[j] + w2g[j] * xg[j] + bg[j], V = w0v[j] * v2[j] + w1v[j] * v1[j] + w2v[j] * xv[j] + bv[j]; a[j] = silu_f(G) * V; }
        *(v4u*)(((bf16*)(ws + WS_ACT)) + (size_t)(m0 + r) * FF + jg) = pack8(a);
        if (tail && r >= nrows - 2) { float* o = offn + (size_t)(r - (nrows - 2)) * FF2;
            *(f32x4*)(o + jg) = (f32x4){xg[0], xg[1], xg[2], xg[3]}; *(f32x4*)(o + jg + 4) = (f32x4){xg[4], xg[5], xg[6], xg[7]};
            *(f32x4*)(o + jv) = (f32x4){xv[0], xv[1], xv[2], xv[3]}; *(f32x4*)(o + jv + 4) = (f32x4){xv[4], xv[5], xv[6], xv[7]}; }
#pragma unroll
        for (int j = 0; j < 8; ++j) { g2[j] = g1[j]; g1[j] = xg[j]; v2[j] = v1[j]; v1[j] = xv[j]; }
    }
#undef LD8F
}
__device__ __forceinline__ void p6_conv_ffn(Ctx& F, int l) {
    const int gw = F.bid * NWAVES + F.wave, NGW = F.G * NWAVES;
    constexpr int NITEMS = (512 + NS) * 11;
    for (int it = gw; it < NITEMS; it += NGW) conv_ffn_item(F, l, it);
}

__device__ __forceinline__ int opq(int v) { asm volatile("" : "+s"(v)); return v; }
struct Args { const float* in[24]; float* out; unsigned char* ws; int ph_lo, ph_hi; };
__global__ void __launch_bounds__(NTHREADS, 2) fwd(Args args) {
    extern __shared__ __attribute__((aligned(16))) unsigned char lds_raw[];
    Ctx F;
    F.lds = (LAS unsigned char*)lds_raw;
    volatile LAS unsigned* MISC = (volatile LAS unsigned*)(F.lds + MISC_OFF);
    F.tid = threadIdx.x; F.lane = F.tid & 63; F.wave = __builtin_amdgcn_readfirstlane(F.tid >> 6);
    F.G = gridDim.x; F.bid = blockIdx.x;
    gu32* ctl = (gu32*)(args.ws + WS_CTL);
    for (int u = F.tid; u < (LDS_BYTES - MISC_OFF) / 4; u += NTHREADS) ((LAS unsigned*)(F.lds + MISC_OFF))[u] = 0u;
    __syncthreads();
#if MK_PER_PHASE
#define SEAM(k) do { } while (0)
#else
    XcdBarrier bar = xcd_barrier_post((unsigned*)(ctl + CW_BAR), MISC + 8);
#define SEAM(k) do { if (lo <= (k) && (k) + 1 < hi) xcd_barrier(bar); } while (0)
#endif
    const int lo = args.ph_lo, hi = args.ph_hi;
#define IN(k) (lo <= (k) && (k) < hi)
    if (IN(0)) { T0(p0a_prologue(F)); }
    SEAM(0);
    if (IN(1)) {
        pg8::Gemm g{((bf16*)(kws() + WS_SC)), ((bf16*)(kws() + WS_WADA)), 256, NMODALL, DM}; pg8::StaticOrder S; S.init(256, NMODALL, DM, F.G, opq(F.bid));
        pg8::EpiF32 E{((float*)(kws() + WS_MOD)), NMODALL, karg(7), nullptr};
        GG0(pg8::gemm_phase<pg8::EpiF32, pg8::StaticOrder, true, true>(F.lds, g, S, E);)
    }
    SEAM(1);
    if (IN(2)) { T1(p0c_h0(F)); }
    SEAM(2);
#pragma unroll 1
    for (int l = 0; l < NL; ++l) {
        const int pb = 3 + 8 * l;
        if (IN(pb + 0)) {
            pg8::Gemm g{((bf16*)(kws() + WS_H)), ((bf16*)(kws() + WS_WIN)) + (size_t)l * INC * DM, M, INC, DM}; pg8::StaticOrder S; S.init(M, INC, DM, F.G, opq(F.bid));
            pg8::EpiBf16G E{((bf16*)(kws() + WS_PROJ)), INC, 8};
            GG1(pg8::gemm_phase<pg8::EpiBf16G, pg8::StaticOrder, true, true>(F.lds, g, S, E);)
        }
        SEAM(pb + 0);
        if (IN(pb + 1)) { T2(p2_mixer(F, l)); }
        SEAM(pb + 1);
        if (IN(pb + 2)) {
            pg8::Gemm g{((bf16*)(kws() + WS_MRG)), ((bf16*)(kws() + WS_WOUT)) + (size_t)l * DM * DM, M, DM, DM}; pg8::SplitOrder S; S.init(DM, F.G, opq(F.bid));
            pg8::EpiF32 E{((float*)(kws() + WS_Y)), DM, nullptr, ((float*)(kws() + WS_PART))};
            GG2(pg8::gemm_phase<pg8::EpiF32, pg8::SplitOrder, true, true>(F.lds, g, S, E);)
        }
        SEAM(pb + 2);
        if (IN(pb + 3)) { T3(row_update<true>(F, l)); }
        SEAM(pb + 3);
        if (IN(pb + 4)) {
            pg8::Gemm g{((bf16*)(kws() + WS_H)), ((bf16*)(kws() + WS_WUP)) + (size_t)l * FF2 * DM, M, FF2, DM}; pg8::StaticOrder S; S.init(M, FF2, DM, F.G, opq(F.bid));
            pg8::EpiBf16G E{((bf16*)(kws() + WS_UP)), FF2, 0};
            GG3(pg8::gemm_phase<pg8::EpiBf16G, pg8::StaticOrder, true, true>(F.lds, g, S, E);)
        }
        SEAM(pb + 4);
        if (IN(pb + 5)) { T4(p6_conv_ffn(F, l)); }
        SEAM(pb + 5);
        if (IN(pb + 6)) {
            pg8::Gemm g{((bf16*)(kws() + WS_ACT)), ((bf16*)(kws() + WS_WDN)) + (size_t)l * DM * FF, M, DM, FF}; pg8::SplitOrder S; S.init(FF, F.G, opq(F.bid));
            pg8::EpiF32 E{((float*)(kws() + WS_Y)), DM, nullptr, ((float*)(kws() + WS_PART))};
            GG4(pg8::gemm_phase<pg8::EpiF32, pg8::SplitOrder, true, true>(F.lds, g, S, E);)
        }
        SEAM(pb + 6);
        if (IN(pb + 7)) { T5(row_update<false>(F, l)); }
        SEAM(pb + 7);
    }
#undef IN
#undef SEAM
}

extern "C" void kernel_launch(void* const* d_in, const int* in_sizes, int n_in, void* d_out, int out_size, void* d_ws, size_t ws_size, hipStream_t stream) {
    static int grid = 0;
    if (grid == 0) {
        if (n_in != 24 || in_sizes[0] != MP * DM || (size_t)out_size != O_END || ws_size < WS_END) {
            fprintf(stderr, "kernel_launch: unexpected shapes (n_in %d, in0 %d, out %d, ws %zu); nothing launched\n", n_in, n_in > 0 ? in_sizes[0] : -1, out_size, ws_size); grid = -1; return; }
        int dev = 0, cus = 0, per_cu = 0;
        if (hipGetDevice(&dev) != hipSuccess || hipDeviceGetAttribute(&cus, hipDeviceAttributeMultiprocessorCount, dev) != hipSuccess) { grid = -1; return; }
        if (hipFuncSetAttribute((const void*)fwd, hipFuncAttributeMaxDynamicSharedMemorySize, LDS_BYTES) != hipSuccess) { fprintf(stderr, "kernel_launch: hipFuncSetAttribute failed\n"); grid = -1; return; }
        if (hipOccupancyMaxActiveBlocksPerMultiprocessor(&per_cu, (const void*)fwd, NTHREADS, LDS_BYTES) != hipSuccess || per_cu < 1) { fprintf(stderr, "kernel_launch: occupancy query says %d blocks per CU\n", per_cu); }
        (void)hipGetLastError();
        grid = cus;
    }
    if (grid < 0) return;
    if (hipMemsetAsync((char*)d_ws + WS_CTL, 0, CTL_ZERO_BYTES, stream) != hipSuccess) return;
    Args a{};
    for (int i = 0; i < 24; ++i) a.in[i] = (const float*)d_in[i];
    a.out = (float*)d_out; a.ws = (unsigned char*)d_ws;
#if MK_PER_PHASE
    for (int p = 0; p < NPHASES; ++p) { a.ph_lo = p; a.ph_hi = p + 1; hipLaunchKernelGGL(fwd, dim3(grid), dim3(NTHREADS), LDS_BYTES, stream, a); }
#else
    a.ph_lo = 0; a.ph_hi = NPHASES;
    hipLaunchKernelGGL(fwd, dim3(grid), dim3(NTHREADS), LDS_BYTES, stream, a);
#endif
    const hipError_t le = hipPeekAtLastError();
    if (le != hipSuccess) fprintf(stderr, "kernel_launch: launch failed: %s\n", hipGetErrorName(le));
}
```

```cpp
#include <hip/hip_runtime.h>
#include <cstdio>
#include <cstdint>
#ifndef MK_PER_PHASE
#define MK_PER_PHASE 0
#endif
#ifndef REP_GEMM
#define REP_GEMM 1
#endif
#ifndef REP_PRO
#define REP_PRO 1
#endif
#ifndef REP_MIX
#define REP_MIX 1
#endif
#ifndef REP_CONV
#define REP_CONV 1
#endif
#define GG0(...) for (int _r = 0; _r < REP_GEMM; ++_r) { __VA_ARGS__ }
#define GG1(...) for (int _r = 0; _r < REP_GEMM; ++_r) { __VA_ARGS__ }
#define GG2(...) for (int _r = 0; _r < REP_GEMM; ++_r) { __VA_ARGS__ }
#define GG3(...) for (int _r = 0; _r < REP_GEMM; ++_r) { __VA_ARGS__ }
#define GG4(...) for (int _r = 0; _r < REP_GEMM; ++_r) { __VA_ARGS__ }
#define T0(...) for (int _r = 0; _r < REP_PRO; ++_r) { __VA_ARGS__; }
#define T1(...) __VA_ARGS__
#define T2(...) for (int _r = 0; _r < REP_MIX; ++_r) { __VA_ARGS__; }
#define T3(...) __VA_ARGS__
#define T4(...) for (int _r = 0; _r < REP_CONV; ++_r) { __VA_ARGS__; }
#define T5(...) __VA_ARGS__
#define MA(...) __VA_ARGS__
#define MB(...) __VA_ARGS__
namespace pg8 {
#define PG8_LAS __attribute__((address_space(3)))
typedef unsigned short bf16_t;
typedef short bf16x8 __attribute__((ext_vector_type(8)));
typedef float f32x4 __attribute__((ext_vector_type(4)));
typedef unsigned u32x4 __attribute__((ext_vector_type(4)));
constexpr int BM = 256, BK = 64, HALF = 128, HTB = HALF * BK * 2  , STAGE_BYTES = 8 * HTB, NXCD = 8, WGM = 8;

__host__ __device__ __forceinline__ int lds_byte(int r, int c) { const int st = (r >> 4) * 2 + (c >> 5), rr = r & 15, cc = c & 31, ob = rr * 64 + cc * 2; return st * 1024 + (ob ^ (((ob >> 9) & 1) << 5)); }
__host__ __device__ __forceinline__ void stage_rc(int b, int& R, int& C) { const int st = b / 1024, sb = b % 1024, swz = sb ^ (((sb >> 9) & 1) << 5); R = (st >> 1) * 16 + swz / 64; C = (st & 1) * 32 + (swz % 64) / 2; }
__host__ __device__ __forceinline__ int perm32(int rho) { const int n = rho >> 4, i = rho & 15; return 8 * (i >> 2) + 4 * n + (i & 3); }

struct Unit { int pm, pn, ks; };
struct Gemm { const bf16_t* A; const bf16_t* Bt; int M, N, K; };

struct StaticOrder {
    int nM, nN, nwg, G, c, KT;
    __host__ __device__ void init(int M, int N, int K, int G_, int c_) { nM = M / BM; nN = N / BM; nwg = nM * nN; G = G_; c = c_; KT = K / BK; }
    __host__ __device__ bool next(int i, Unit& u) const {
        const long L = (long)i * G + c; if (L >= nwg) return false;
        int wgid = (int)L; { const int q = nwg / NXCD, r = nwg % NXCD, xcd = wgid % NXCD, off = wgid / NXCD; wgid = (xcd < r ? xcd * (q + 1) : r * (q + 1) + (xcd - r) * q) + off; }
        const int nig = WGM * nN, gid = wgid / nig, fm = gid * WGM, gsz = (nM - fm) < WGM ? (nM - fm) : WGM;
        u.pm = fm + ((wgid % nig) % gsz); u.pn = (wgid % nig) / gsz; u.ks = -1; return true;
    }
    __device__ __forceinline__ int k0(const Unit&) const { return 0; }
    __device__ __forceinline__ int nt(const Unit&) const { return KT; }
    __device__ __forceinline__ void a_ready(const Unit&) const {}
    __device__ __forceinline__ void done(const Unit&) const {}
};
struct SplitOrder {
    int G, c, KB;
    __host__ __device__ void init(int K, int G_, int c_) { G = G_; c = c_; KB = K / 128; }
    __host__ __device__ bool next(int i, Unit& u) const {
        const int L = i * G + c; if (L >= 512) return false;
        if (L < 256) { const int x = L & 7, j = L >> 3; u.pm = 4 * x + (j >> 3); u.pn = j & 7; u.ks = -1; }
        else { const int Ls = L - 256, j = Ls >> 3; u.pm = 32 + (j >> 3); u.pn = j & 7; u.ks = Ls & 7; }
        return true;
    }
    __device__ __forceinline__ int k0(const Unit& u) const { const int base = KB >> 3, rem = KB & 7; return u.ks < 0 ? 0 : 128 * (u.ks * base + (u.ks < rem ? u.ks : rem)); }
    __device__ __forceinline__ int nt(const Unit& u) const { const int base = KB >> 3, rem = KB & 7; return u.ks < 0 ? 2 * KB : 2 * (base + (u.ks < rem ? 1 : 0)); }
    __device__ __forceinline__ void a_ready(const Unit&) const {}
    __device__ __forceinline__ void done(const Unit&) const {}
};

__device__ __forceinline__ unsigned cvt_pk_bf16(float lo, float hi) { unsigned r; asm volatile("v_cvt_pk_bf16_f32 %0, %1, %2" : "=v"(r) : "v"(lo), "v"(hi)); return r; }
typedef float f32x2 __attribute__((ext_vector_type(2)));
__device__ __forceinline__ float gelu_tanh(float x) {
    const float z = x * (1.5957691216f + 0.0713548163f * x * x);
    const float e = __builtin_amdgcn_exp2f(-1.4426950409f * z);
    return x * __builtin_amdgcn_rcpf(1.0f + e);
}
struct EpiBf16G {
    static constexpr bool PERM = true, AFTER_DRAIN = false;
    bf16_t* O; int ldc; int ngelu;
    __device__ __forceinline__ void operator()(const f32x4 (&acc)[2][2][4][2], const Unit& u, int wr, int wc, int fr, int fq) const {
        const int row0 = u.pm * BM + wr * 64 + fr; const int col0 = u.pn * BM + wc * 32 + 8 * fq;
        const bool act = u.pn < ngelu;
#pragma unroll
        for (int ai = 0; ai < 2; ++ai)
#pragma unroll
            for (int m = 0; m < 4; ++m) { bf16_t* rowp = O + (size_t)(row0 + ai * HALF + m * 16) * ldc + col0;
#pragma unroll
                for (int bj = 0; bj < 2; ++bj) { f32x4 v0 = acc[ai][bj][m][0], v1 = acc[ai][bj][m][1];
                    if (act) {
#pragma unroll
                        for (int j = 0; j < 4; ++j) { v0[j] = gelu_tanh(v0[j]); v1[j] = gelu_tanh(v1[j]); } }
                    u32x4 w; w.x = cvt_pk_bf16(v0[0], v0[1]); w.y = cvt_pk_bf16(v0[2], v0[3]); w.z = cvt_pk_bf16(v1[0], v1[1]); w.w = cvt_pk_bf16(v1[2], v1[3]);
                    *(u32x4*)(rowp + bj * HALF) = w; } }
    }
};
struct EpiF32 {
    static constexpr bool PERM = false, AFTER_DRAIN = false;
    float* C; int ldc; const float* bias; float* Cpart;
    __device__ __forceinline__ void operator()(const f32x4 (&acc)[2][2][4][2], const Unit& u, int wr, int wc, int fr, int fq) const {
        const int row0 = u.pm * BM + wr * 64 + fr, col0 = u.pn * BM + wc * 32 + 4 * fq;
        float* Cb = u.ks < 0 ? C : Cpart + (ptrdiff_t)(u.ks * 1024 - 32 * BM) * ldc;
        f32x4 bv[2][2];
#pragma unroll
        for (int bj = 0; bj < 2; ++bj)
#pragma unroll
            for (int n = 0; n < 2; ++n) bv[bj][n] = bias ? *(const f32x4*)(bias + col0 + bj * HALF + n * 16) : (f32x4){0.f, 0.f, 0.f, 0.f};
#pragma unroll
        for (int ai = 0; ai < 2; ++ai)
#pragma unroll
            for (int m = 0; m < 4; ++m) { float* rowp = Cb + (size_t)(row0 + ai * HALF + m * 16) * ldc + col0;
#pragma unroll
                for (int bj = 0; bj < 2; ++bj)
#pragma unroll
                    for (int n = 0; n < 2; ++n) *(f32x4*)(rowp + bj * HALF + n * 16) = acc[ai][bj][m][n] + bv[bj][n]; }
    }
};
template <class Epi, class Sched, bool ALIGN_EPI = false, bool SP2 = false>
__device__ __forceinline__ void gemm_phase(PG8_LAS unsigned char* lds, const Gemm g, const Sched& S, const Epi& E) {
    int tid_ = threadIdx.x; asm volatile("" : "+v"(tid_));
    const int tid = tid_, wid = __builtin_amdgcn_readfirstlane(tid >> 6), lane = tid & 63, wr = wid >> 2, wc = wid & 3, fr = lane & 15, fq = lane >> 4;
    const int K = g.K;
    unsigned voffA[2], voffB[2];
#pragma unroll
    for (int i = 0; i < 2; ++i) { int R, C; stage_rc(tid * 16 + i * 8192, R, C); const int Rb = Epi::PERM ? ((R & ~31) + perm32(R & 31)) : R;
        voffA[i] = (unsigned)(R * K + C) * 2u; voffB[i] = (unsigned)(Rb * K + C) * 2u; }
    const size_t kstep = (size_t)(BK * 2);
    const size_t hstep = (size_t)HALF * K * 2;
    const size_t tstep = 2 * hstep;
    const unsigned ldsw = (unsigned)wid * 1024u;
    const int aoff = lds_byte(wr * 64 + fr, fq * 8), boff = lds_byte(wc * 32 + fr, fq * 8);
#define PG8_SA(b, h) (((b) * 2 + (h)) * HTB)
#define PG8_SB(b, h) ((4 + (b) * 2 + (h)) * HTB)
#define PG8_STAGE(bufoff, gbase, voff) do { _Pragma("unroll") for (int _i = 0; _i < 2; ++_i) \
        __builtin_amdgcn_global_load_lds((const unsigned*)((const char*)(gbase) + (voff)[_i]), (PG8_LAS unsigned*)(lds + (bufoff) + ldsw + _i * 8192), 16, 0, 0); } while (0)
#define PG8_LDA(dst, b, h) do { _Pragma("unroll") for (int m = 0; m < 4; ++m) _Pragma("unroll") for (int k = 0; k < 2; ++k) dst[m][k] = *(const PG8_LAS bf16x8*)(lds + PG8_SA(b, h) + aoff + m * 2048 + k * 1024); } while (0)
#define PG8_LDB(dst, b, h) do { _Pragma("unroll") for (int n = 0; n < 2; ++n) _Pragma("unroll") for (int k = 0; k < 2; ++k) dst[n][k] = *(const PG8_LAS bf16x8*)(lds + PG8_SB(b, h) + boff + n * 2048 + k * 1024); } while (0)
#define PG8_MMA(ai, bj, At, Bt) do { __builtin_amdgcn_s_setprio(1); _Pragma("unroll") for (int m = 0; m < 4; ++m) _Pragma("unroll") for (int n = 0; n < 2; ++n) _Pragma("unroll") for (int k = 0; k < 2; ++k) \
        acc[ai][bj][m][n] = __builtin_amdgcn_mfma_f32_16x16x32_bf16(Bt[n][k], At[m][k], acc[ai][bj][m][n], 0, 0, 0); __builtin_amdgcn_s_setprio(0); } while (0)
#define PG8_WAIT_V(n) asm volatile("s_waitcnt vmcnt(" #n ")" ::: "memory")
#define PG8_WAIT_L(n) asm volatile("s_waitcnt lgkmcnt(" #n ")" ::: "memory")
#define PG8_BAR __builtin_amdgcn_s_barrier()
#define PG8_SCHED __builtin_amdgcn_sched_barrier(0)
    Unit cur, nxt; int ui = 0;
    if (!S.next(0, cur)) return;
    f32x4 acc[2][2][4][2];
#pragma unroll
    for (int a = 0; a < 2; ++a)
#pragma unroll
        for (int b = 0; b < 2; ++b)
#pragma unroll
            for (int m = 0; m < 4; ++m)
#pragma unroll
                for (int n = 0; n < 2; ++n) acc[a][b][m][n] = (f32x4){0.f, 0.f, 0.f, 0.f};
    bf16x8 At[4][2], B0[2][2], B1[2][2];
    const char* cA = (const char*)g.A + (size_t)cur.pm * tstep + (size_t)S.k0(cur) * 2; const char* cB = (const char*)g.Bt + (size_t)cur.pn * tstep + (size_t)S.k0(cur) * 2;
    S.a_ready(cur);
    if constexpr (SP2) {
        PG8_STAGE(PG8_SB(0, 0), cB, voffB); PG8_STAGE(PG8_SB(0, 1), cB + hstep, voffB); PG8_STAGE(PG8_SA(0, 0), cA, voffA); PG8_STAGE(PG8_SA(0, 1), cA + hstep, voffA);
        if (wr == 1) PG8_BAR;
        PG8_WAIT_V(2); PG8_BAR;
        PG8_STAGE(PG8_SB(1, 0), cB + kstep, voffB); PG8_STAGE(PG8_SA(1, 0), cA + kstep, voffA); PG8_STAGE(PG8_SB(1, 1), cB + hstep + kstep, voffB);
        PG8_WAIT_V(6); PG8_BAR;
    } else {
        PG8_STAGE(PG8_SB(0, 0), cB, voffB); PG8_STAGE(PG8_SA(0, 0), cA, voffA); PG8_STAGE(PG8_SB(0, 1), cB + hstep, voffB); PG8_STAGE(PG8_SA(0, 1), cA + hstep, voffA);
        if (wr == 1) PG8_BAR;
        PG8_WAIT_V(4); PG8_BAR;
        PG8_STAGE(PG8_SB(1, 0), cB + kstep, voffB); PG8_STAGE(PG8_SA(1, 0), cA + kstep, voffA); PG8_STAGE(PG8_SB(1, 1), cB + hstep + kstep, voffB);
        PG8_WAIT_V(6); PG8_BAR;
    }
    for (;;) {
        const bool has_next = S.next(ui + 1, nxt);
        const char* nA = has_next ? (const char*)g.A + (size_t)nxt.pm * tstep + (size_t)S.k0(nxt) * 2 : cA; const char* nB = has_next ? (const char*)g.Bt + (size_t)nxt.pn * tstep + (size_t)S.k0(nxt) * 2 : cB;
        const int nt = S.nt(cur);
        for (int t = 0; t < nt; t += 2) {
            const bool last = (t == nt - 2);
            const char* a1 = cA + (size_t)(t + 1) * kstep;
            const char* a2 = last ? nA : cA + (size_t)(t + 2) * kstep; const char* b2 = last ? nB : cB + (size_t)(t + 2) * kstep;
            const char* a3 = a2 + kstep; const char* b3 = b2 + kstep;
            if (last && has_next) S.a_ready(nxt);
            if constexpr (SP2) {
            PG8_LDB(B0, 0, 0); PG8_LDB(B1, 0, 1); PG8_SCHED; PG8_LDA(At, 0, 0); PG8_STAGE(PG8_SA(1, 1), a1 + hstep, voffA);
            PG8_WAIT_V(8); PG8_WAIT_L(0); PG8_BAR; PG8_MMA(0, 0, At, B0); PG8_MMA(0, 1, At, B1); PG8_BAR; PG8_SCHED;
            PG8_LDA(At, 0, 1); PG8_STAGE(PG8_SB(0, 0), b2, voffB); PG8_STAGE(PG8_SB(0, 1), b2 + hstep, voffB); PG8_STAGE(PG8_SA(0, 0), a2, voffA);
            PG8_WAIT_V(8); PG8_WAIT_L(0); PG8_BAR; PG8_MMA(1, 0, At, B0); PG8_MMA(1, 1, At, B1); PG8_BAR; PG8_SCHED;
            PG8_LDB(B0, 1, 0); PG8_LDB(B1, 1, 1); PG8_SCHED; PG8_LDA(At, 1, 0); PG8_STAGE(PG8_SA(0, 1), a2 + hstep, voffA);
            PG8_WAIT_V(8); PG8_WAIT_L(0); PG8_BAR; PG8_MMA(0, 0, At, B0); PG8_MMA(0, 1, At, B1); PG8_BAR; PG8_SCHED;
            PG8_LDA(At, 1, 1); PG8_STAGE(PG8_SB(1, 0), b3, voffB); PG8_STAGE(PG8_SB(1, 1), b3 + hstep, voffB); PG8_STAGE(PG8_SA(1, 0), a3, voffA);
            PG8_WAIT_V(8); PG8_WAIT_L(0); PG8_BAR; PG8_MMA(1, 0, At, B0); PG8_MMA(1, 1, At, B1); PG8_BAR; PG8_SCHED;
            } else {
            PG8_LDB(B0, 0, 0); PG8_SCHED; PG8_LDA(At, 0, 0); PG8_STAGE(PG8_SA(1, 1), a1 + hstep, voffA);
            PG8_WAIT_L(8); PG8_BAR; PG8_WAIT_L(0); PG8_MMA(0, 0, At, B0); PG8_BAR; PG8_SCHED;
            PG8_LDB(B1, 0, 1); PG8_STAGE(PG8_SB(0, 0), b2, voffB);
            PG8_BAR; PG8_WAIT_L(0); PG8_MMA(0, 1, At, B1); PG8_BAR;
            PG8_LDA(At, 0, 1); PG8_STAGE(PG8_SA(0, 0), a2, voffA);
            PG8_BAR; PG8_WAIT_L(0); PG8_MMA(1, 0, At, B0); PG8_BAR; PG8_SCHED;
            PG8_STAGE(PG8_SB(0, 1), b2 + hstep, voffB);
            PG8_WAIT_V(6); PG8_BAR; PG8_MMA(1, 1, At, B1); PG8_BAR;
            PG8_LDB(B0, 1, 0); PG8_SCHED; PG8_LDA(At, 1, 0); PG8_STAGE(PG8_SA(0, 1), a2 + hstep, voffA);
            PG8_WAIT_L(8); PG8_BAR; PG8_WAIT_L(0); PG8_MMA(0, 0, At, B0); PG8_BAR; PG8_SCHED;
            PG8_LDB(B1, 1, 1); PG8_STAGE(PG8_SB(1, 0), b3, voffB);
            PG8_BAR; PG8_WAIT_L(0); PG8_MMA(0, 1, At, B1); PG8_BAR;
            PG8_LDA(At, 1, 1); PG8_STAGE(PG8_SA(1, 0), a3, voffA);
            PG8_BAR; PG8_WAIT_L(0); PG8_MMA(1, 0, At, B0); PG8_BAR; PG8_SCHED;
            PG8_STAGE(PG8_SB(1, 1), b3 + hstep, voffB);
            PG8_WAIT_V(6); PG8_BAR; PG8_MMA(1, 1, At, B1); PG8_BAR;
            }
        }
        if constexpr (ALIGN_EPI) { if (wr == 0) PG8_BAR; }
        if constexpr (!Epi::AFTER_DRAIN) { E(acc, cur, wr, wc, fr, fq); S.done(cur); }
        if (!has_next) break;
#pragma unroll
        for (int a = 0; a < 2; ++a)
#pragma unroll
            for (int b = 0; b < 2; ++b)
#pragma unroll
                for (int m = 0; m < 4; ++m)
#pragma unroll
                    for (int n = 0; n < 2; ++n) acc[a][b][m][n] = (f32x4){0.f, 0.f, 0.f, 0.f};
        cur = nxt; cA = nA; cB = nB; ++ui;
        if constexpr (ALIGN_EPI) { if (wr == 1) PG8_BAR; }
    }
    PG8_WAIT_V(0);
    if constexpr (!ALIGN_EPI) { if (wr == 0) PG8_BAR; }
    PG8_BAR;
    if constexpr (Epi::AFTER_DRAIN) { E.fused(acc, cur, wr, wc, fr, fq, lds, wid, lane); S.done(cur); }
#undef PG8_SA
#undef PG8_SB
#undef PG8_STAGE
#undef PG8_LDA
#undef PG8_LDB
#undef PG8_MMA
#undef PG8_WAIT_V
#undef PG8_WAIT_L
#undef PG8_BAR
#undef PG8_SCHED
}
}

constexpr int DM = 2048, NP = 4, TP = 2048, NL = 4, NS = 128, TS = 8;
constexpr int MP = NP * TP, MS = NS * TS, M = MP + MS;
constexpr int WA = 1024, WB = 1024, INC = 5120, FF = 5632, FF2 = 2 * FF, NMOD = 6 * DM, NMODALL = NL * NMOD;
constexpr int NSEQ = NP + NS;
constexpr float EPS = 1e-6f;
constexpr size_t O_YP = 0, O_YS = O_YP + (size_t)MP * DM, O_MIXP = O_YS + (size_t)MS * DM, O_MIXS = O_MIXP + (size_t)NP * NL * 2 * WB,
                 O_FFNP = O_MIXS + (size_t)NS * NL * 2 * WB, O_FFNS = O_FFNP + (size_t)NP * NL * 2 * FF2, O_CVP = O_FFNS + (size_t)NS * NL * 2 * FF2,
                 O_CVS = O_CVP + (size_t)NP * NL * 128 * WA, O_END = O_CVS + (size_t)NS * NL * TS * WA;
static_assert(O_END == 38141952, "output size");
constexpr size_t MiB = 1u << 20;
constexpr size_t WS_CTL = 0, CTL_ZERO_BYTES = 1 * MiB;
constexpr size_t WS_SC = 1 * MiB;
constexpr size_t WS_MOD = 2 * MiB;
constexpr size_t WS_WIN = 50 * MiB, WS_WOUT = 130 * MiB, WS_WUP = 162 * MiB, WS_WDN = 338 * MiB, WS_WADA = 426 * MiB;
constexpr size_t WS_X = 618 * MiB, WS_H = 690 * MiB, WS_PROJ = 726 * MiB, WS_MRG = 816 * MiB, WS_Y = 852 * MiB, WS_UP = 924 * MiB, WS_ACT = 1122 * MiB, WS_PART = 1221 * MiB, WS_END = 1285 * MiB;
static_assert(WS_MOD + (size_t)256 * NMODALL * 4 <= WS_WIN && WS_WIN + (size_t)NL * INC * DM * 2 <= WS_WOUT && WS_WOUT + (size_t)NL * DM * DM * 2 <= WS_WUP &&
              WS_WUP + (size_t)NL * FF2 * DM * 2 <= WS_WDN && WS_WDN + (size_t)NL * DM * FF * 2 <= WS_WADA && WS_WADA + (size_t)NMODALL * DM * 2 <= WS_X &&
              WS_X + (size_t)M * DM * 4 <= WS_H && WS_H + (size_t)M * DM * 2 <= WS_PROJ && WS_PROJ + (size_t)M * INC * 2 <= WS_MRG && WS_MRG + (size_t)M * DM * 2 <= WS_Y &&
              WS_Y + (size_t)M * DM * 4 <= WS_UP && WS_UP + (size_t)M * FF2 * 2 <= WS_ACT && WS_ACT + (size_t)M * FF * 2 <= WS_PART && WS_PART + (size_t)8 * MS * DM * 4 <= WS_END, "d_ws map");
constexpr int CW_BAR = 4096;
constexpr int RING_BYTES = 131072;
constexpr int MISC_OFF = RING_BYTES;
constexpr int TAB_OFF = RING_BYTES + 1024;
constexpr int LDS_BYTES = 147456;
constexpr int NWAVES = 8, NTHREADS = 512;
constexpr int NPHASES = 3 + 8 * NL;

#define GAS __attribute__((address_space(1)))
#define LAS __attribute__((address_space(3)))
typedef unsigned short bf16;
typedef unsigned v4u __attribute__((ext_vector_type(4)));
typedef unsigned v2u __attribute__((ext_vector_type(2)));
typedef float f32x4 __attribute__((ext_vector_type(4)));
typedef short bf16x8 __attribute__((ext_vector_type(8)));
typedef short s16x4 __attribute__((ext_vector_type(4)));
typedef GAS unsigned gu32;
#define RLX_AGENT __ATOMIC_RELAXED, __HIP_MEMORY_SCOPE_AGENT
#define LDS_WAIT() asm volatile("s_waitcnt lgkmcnt(0)" ::: "memory")
#define VM_WAIT() asm volatile("s_waitcnt vmcnt(0)" ::: "memory")
__device__ __forceinline__ unsigned pk2(float lo, float hi) { return pg8::cvt_pk_bf16(lo, hi); }
__device__ __forceinline__ float bflo(unsigned w) { return __builtin_bit_cast(float, w << 16); }
__device__ __forceinline__ float bfhi(unsigned w) { return __builtin_bit_cast(float, w & 0xffff0000u); }
__device__ __forceinline__ void unpack8(const v4u w, float (&f)[8]) { f[0] = bflo(w.x); f[1] = bfhi(w.x); f[2] = bflo(w.y); f[3] = bfhi(w.y); f[4] = bflo(w.z); f[5] = bfhi(w.z); f[6] = bflo(w.w); f[7] = bfhi(w.w); }
__device__ __forceinline__ v4u pack8(const float (&f)[8]) { v4u w; w.x = pk2(f[0], f[1]); w.y = pk2(f[2], f[3]); w.z = pk2(f[4], f[5]); w.w = pk2(f[6], f[7]); return w; }
__device__ __forceinline__ float wave_sum(float v) {
#pragma unroll
    for (int o = 1; o < 64; o <<= 1) v += __shfl_xor(v, o);
    return v;
}
__device__ __forceinline__ float silu_f(float x) { return x * __builtin_amdgcn_rcpf(1.0f + __builtin_amdgcn_exp2f(-1.4426950409f * x)); }

#define XB_TMO      128
#define XB_XCNT(j)  (256  + 64 * (j))
#define XB_XSUB(j)  (1280 + 64 * (j))
#define XB_XGEN(j)  (2304 + 64 * (j))
#define XB_TOP      3328
#define XB_TOPGEN   3392
#define XCD_BAR_WORDS 3456
#define XB_SPIN_CAP (1u << 18)

__device__ __forceinline__ unsigned xb_ld(unsigned* p)              { return __hip_atomic_load(p, __ATOMIC_RELAXED, __HIP_MEMORY_SCOPE_AGENT); }
__device__ __forceinline__ unsigned xb_add(unsigned* p, unsigned v) { return __hip_atomic_fetch_add(p, v, __ATOMIC_RELAXED, __HIP_MEMORY_SCOPE_AGENT); }
__device__ __forceinline__ unsigned xb_xcc_id() { return (unsigned)__builtin_amdgcn_s_getreg((3 << 11) | 20) & 0xFu; }
#define XB_SPIN(cond, bar) do { unsigned _sp = 0; while (cond) { __builtin_amdgcn_s_sleep(1); \
    if ((++_sp & 255u) == 0u) { if (xb_ld(&(bar)[XB_TMO])) break; if (_sp > XB_SPIN_CAP) { atomicAdd(&(bar)[XB_TMO], 1u); break; } } } } while (0)

struct XcdBarrier {
    unsigned* bar; unsigned x;
    volatile LAS unsigned* st;
};

__device__ __forceinline__ XcdBarrier xcd_barrier_post(unsigned* bar, volatile LAS unsigned* st) {
    XcdBarrier b; b.bar = bar; b.x = xb_xcc_id(); b.st = st;
    if (threadIdx.x == 0) (void)xb_add(&bar[XB_XCNT(b.x)], 1u);
    return b;
}
__device__ __forceinline__ void xcd_barrier_complete(unsigned* bar, unsigned x, unsigned& nloc, unsigned& nx) {
    const unsigned G = gridDim.x * gridDim.y * gridDim.z;
    unsigned sum, cnt, mine, sp = 0u;
    for (;;) {
        sum = 0u; cnt = 0u; mine = 0u;
#pragma unroll
        for (unsigned j = 0; j < 16; ++j) { const unsigned c = xb_ld(&bar[XB_XCNT(j)]); sum += c; cnt += (c > 0u) ? 1u : 0u; mine = (j == x) ? c : mine; }
        if (sum == G) break;
        __builtin_amdgcn_s_sleep(1);
        if ((++sp & 255u) == 0u) { if (xb_ld(&bar[XB_TMO])) break; if (sp > XB_SPIN_CAP) { atomicAdd(&bar[XB_TMO], 1u); break; } }
    }
    nloc = mine > 0u ? mine : 1u; nx = cnt > 0u ? cnt : 1u;
}

__device__ __forceinline__ void xcd_barrier(const XcdBarrier& b) {
    asm volatile("s_waitcnt vmcnt(0)" ::: "memory");
    __syncthreads();
    if (threadIdx.x == 0) {
        unsigned* bar = b.bar;
        __builtin_amdgcn_s_waitcnt(0);
        unsigned nloc = b.st[0], nx = b.st[1];
        if (nloc == 0u) { xcd_barrier_complete(bar, b.x, nloc, nx); b.st[0] = nloc; b.st[1] = nx; }
        const unsigned old = xb_add(&bar[XB_XSUB(b.x)], 1u);
        const unsigned gen = old / nloc;
        if (old + 1u == (gen + 1u) * nloc) {
            __builtin_amdgcn_fence(__ATOMIC_RELEASE, "agent");
            asm volatile("s_waitcnt vmcnt(0)" ::: "memory");
            const unsigned og = xb_add(&bar[XB_TOP], 1u);
            const unsigned tg = og / nx;
            if (og + 1u == (tg + 1u) * nx) xb_add(&bar[XB_TOPGEN], 1u);
            else XB_SPIN(xb_ld(&bar[XB_TOPGEN]) == tg, bar);
            __builtin_amdgcn_fence(__ATOMIC_ACQUIRE, "agent");
            xb_add(&bar[XB_XGEN(b.x)], 1u);
            asm volatile("s_waitcnt vmcnt(0)" ::: "memory");
        } else {
            XB_SPIN(xb_ld(&bar[XB_XGEN(b.x)]) == gen, bar);
            __builtin_amdgcn_fence(__ATOMIC_ACQUIRE, "agent");
            asm volatile("s_waitcnt vmcnt(0)" ::: "memory");
        }
    }
    __syncthreads();
}


struct Ctx {
    LAS unsigned char* lds;
    int tid, lane, wave, G, bid;
};
__device__ __forceinline__ unsigned long long karg_u64(int byte_off) {
    unsigned long long p; const unsigned long long ka = (unsigned long long)__builtin_amdgcn_kernarg_segment_ptr();
    asm volatile("s_load_dwordx2 %0, %1, %2\n\ts_waitcnt lgkmcnt(0)" : "=s"(p) : "s"(ka), "i"(byte_off) : "memory");
    return p;
}
__device__ __forceinline__ const float* karg(int k) { return (const float*)(const GAS float*)karg_u64(8 * k); }
__device__ __forceinline__ unsigned char* kws() { return (unsigned char*)(GAS unsigned char*)karg_u64(200); }
__device__ __forceinline__ float* kout() { return (float*)(GAS float*)karg_u64(192); }
__device__ __forceinline__ int opqv(int v) { asm volatile("" : "+v"(v)); return v; }
__device__ __forceinline__ int seq_of(int m) { return m < MP ? (m >> 11) : NP + ((m - MP) >> 3); }

__device__ __forceinline__ void p0_transpose_item(const float* W, int K, int N, bf16* WT, LAS float* T, int item, int lane) {
    const int nblk = N >> 6, kb = item / nblk, nb = item - kb * nblk;
    const float* src = W + (size_t)(64 * kb + (lane >> 4)) * N + 64 * nb + 4 * (lane & 15);
    f32x4 v[16];
#pragma unroll
    for (int i = 0; i < 16; ++i) v[i] = __builtin_nontemporal_load((const f32x4*)(src + (size_t)(4 * i) * N));
#pragma unroll
    for (int i = 0; i < 16; ++i) { const int k = 4 * i + (lane >> 4); *(LAS f32x4*)(T + k * 64 + ((4 * (lane & 15)) ^ (((k >> 3) & 7) << 2))) = v[i]; }
    LDS_WAIT(); asm volatile("" ::: "memory");
    const int c = lane & 7, nn = lane >> 3;
    bf16* dst = WT + (size_t)(64 * nb + nn) * K + 64 * kb + 8 * c;
#pragma unroll
    for (int ps = 0; ps < 8; ++ps) {
        const LAS float* t = T + (8 * c) * 64 + ((8 * ps + nn) ^ (c << 2));
        v4u o; o.x = pk2(t[0 * 64], t[1 * 64]); o.y = pk2(t[2 * 64], t[3 * 64]); o.z = pk2(t[4 * 64], t[5 * 64]); o.w = pk2(t[6 * 64], t[7 * 64]);
        *(v4u*)(dst + (size_t)(8 * ps) * K) = o;
    }
    LDS_WAIT(); asm volatile("" ::: "memory");
}
__device__ __forceinline__ void p0a_prologue(Ctx& F) {
    unsigned char* const ws = kws();
    const int lane = opqv(F.lane);
    const int gw = F.bid * NWAVES + F.wave, NGW = F.G * NWAVES;
    LAS float* T = (LAS float*)(F.lds + F.wave * 16384);
    constexpr int I_IN = (DM / 64) * (INC / 64), I_OUT = (DM / 64) * (DM / 64), I_UP = (DM / 64) * (FF2 / 64), I_DN = (FF / 64) * (DM / 64), I_ADA = (DM / 64) * (NMOD / 64);
    constexpr int I_LAYER = I_IN + I_OUT + I_UP + I_DN + I_ADA;
    for (int it = gw; it < NL * I_LAYER; it += NGW) {
        const int l = it / I_LAYER; int r = it - l * I_LAYER;
        const float* W; bf16* WT; int K, N;
        if (r < I_IN)                      { W = karg(12) + (size_t)l * DM * INC;  WT = ((bf16*)(ws + WS_WIN))  + (size_t)l * INC * DM;  K = DM; N = INC; }
        else if ((r -= I_IN) < I_OUT)      { W = karg(19) + (size_t)l * DM * DM;   WT = ((bf16*)(ws + WS_WOUT)) + (size_t)l * DM * DM;   K = DM; N = DM; }
        else if ((r -= I_OUT) < I_UP)      { W = karg(20) + (size_t)l * DM * FF2;  WT = ((bf16*)(ws + WS_WUP))  + (size_t)l * FF2 * DM;  K = DM; N = FF2; }
        else if ((r -= I_UP) < I_DN)       { W = karg(23) + (size_t)l * FF * DM;   WT = ((bf16*)(ws + WS_WDN))  + (size_t)l * DM * FF;   K = FF; N = DM; }
        else { r -= I_DN;                    W = karg(6)  + (size_t)l * DM * NMOD; WT = ((bf16*)(ws + WS_WADA)) + (size_t)l * NMOD * DM; K = DM; N = NMOD; }
        p0_transpose_item(W, K, N, WT, T, r, lane);
    }
    for (int r = gw; r < 256; r += NGW) {
        v2u* o = (v2u*)(((bf16*)(ws + WS_SC)) + (size_t)r * DM) + lane;
        if (r < NSEQ) { const f32x4* c = (const f32x4*)(r < NP ? karg(4) + (size_t)r * DM : karg(5) + (size_t)(r - NP) * DM) + lane;
#pragma unroll
            for (int j = 0; j < 8; ++j) { const f32x4 v = c[64 * j]; v2u w; w.x = pk2(silu_f(v.x), silu_f(v.y)); w.y = pk2(silu_f(v.z), silu_f(v.w)); o[64 * j] = w; } }
        else {
#pragma unroll
            for (int j = 0; j < 8; ++j) o[64 * j] = (v2u){0u, 0u}; }
    }
}
__device__ __forceinline__ const float* x_in_row(const Ctx& F, int m) { return m < MP ? karg(0) + (size_t)m * DM : karg(1) + (size_t)(m - MP) * DM; }
__device__ __forceinline__ void norm_mod_store(const f32x4 (&x)[8], const float* g, const float* sc, const float* sh, bf16* hrow, int lane) {
    float ss = 0.f;
#pragma unroll
    for (int j = 0; j < 8; ++j) ss += (x[j].x * x[j].x + x[j].y * x[j].y) + (x[j].z * x[j].z + x[j].w * x[j].w);
    const float rs = __builtin_amdgcn_rsqf(wave_sum(ss) * (1.0f / DM) + EPS);
    v2u* o = (v2u*)hrow + lane;
#pragma unroll
    for (int j = 0; j < 8; ++j) { const f32x4 gv = ((const f32x4*)g)[lane + 64 * j], sv = ((const f32x4*)sc)[lane + 64 * j], hv = ((const f32x4*)sh)[lane + 64 * j];
        const f32x4 h = x[j] * rs * gv * (sv + 1.0f) + hv; v2u w; w.x = pk2(h.x, h.y); w.y = pk2(h.z, h.w); o[64 * j] = w; }
}
__device__ __forceinline__ void p0c_h0(Ctx& F) {
    unsigned char* const ws = kws();
    const int lane = opqv(F.lane);
    const int gw = F.bid * NWAVES + F.wave, NGW = F.G * NWAVES;
    for (int m = gw; m < M; m += NGW) {
        const float* mod = ((float*)(ws + WS_MOD)) + (size_t)seq_of(m) * NMODALL;
        const f32x4* xr = (const f32x4*)x_in_row(F, m) + lane; f32x4 x[8];
#pragma unroll
        for (int j = 0; j < 8; ++j) x[j] = xr[64 * j];
        norm_mod_store(x, karg(8), mod + DM, mod, ((bf16*)(ws + WS_H)) + (size_t)m * DM, lane);
    }
}
template <bool MID> __device__ __forceinline__ void row_update(Ctx& F, int l) {
    unsigned char* const ws = kws();
    float* const out = kout();
    const int lane = opqv(F.lane);
    const int gw = F.bid * NWAVES + F.wave, NGW = F.G * NWAVES;
    const bool fin = !MID && (l == NL - 1);
    const float* gpost = (MID ? karg(9) : karg(11)) + (size_t)l * DM;
    const float* gpre = MID ? karg(10) + (size_t)l * DM : karg(8) + (size_t)(l + 1 < NL ? l + 1 : l) * DM;
    for (int m = gw; m < M; m += NGW) {
        const float* mod = ((float*)(ws + WS_MOD)) + (size_t)seq_of(m) * NMODALL + (size_t)l * NMOD;
        const float* gt = mod + (MID ? 2 : 5) * DM;
        const float* sc = MID ? mod + 4 * DM : mod + NMOD + DM;
        const float* sh = MID ? mod + 3 * DM : mod + NMOD;
        const f32x4* yr = (const f32x4*)(((float*)(ws + WS_Y)) + (size_t)m * DM) + lane;
        const f32x4* xr = (const f32x4*)((MID && l == 0) ? x_in_row(F, m) : ((float*)(ws + WS_X)) + (size_t)m * DM) + lane;
        f32x4 y[8], x[8]; float ss = 0.f;
#pragma unroll
        for (int j = 0; j < 8; ++j) { y[j] = yr[64 * j]; x[j] = xr[64 * j]; }
        if (m >= MP) {
            const f32x4* pr = (const f32x4*)(((float*)(ws + WS_PART)) + (size_t)(m - MP) * DM) + lane;
#pragma unroll
            for (int j = 0; j < 8; ++j) y[j] = pr[64 * j];
#pragma unroll 1
            for (int ks = 1; ks < 8; ++ks) {
#pragma unroll
                for (int j = 0; j < 8; ++j) y[j] = y[j] + pr[(size_t)ks * (MS * DM / 4) + 64 * j]; }
        }
#pragma unroll
        for (int j = 0; j < 8; ++j) ss += (y[j].x * y[j].x + y[j].y * y[j].y) + (y[j].z * y[j].z + y[j].w * y[j].w);
        const float rs = __builtin_amdgcn_rsqf(wave_sum(ss) * (1.0f / DM) + EPS);
#pragma unroll
        for (int j = 0; j < 8; ++j) { const f32x4 gp = ((const f32x4*)gpost)[lane + 64 * j], gv = ((const f32x4*)gt)[lane + 64 * j]; x[j] = x[j] + gv * (y[j] * rs * gp); }
        if (fin) { f32x4* o = (f32x4*)(out + (size_t)m * DM) + lane;
#pragma unroll
            for (int j = 0; j < 8; ++j) o[64 * j] = x[j]; }
        else { f32x4* o = (f32x4*)(((float*)(ws + WS_X)) + (size_t)m * DM) + lane;
#pragma unroll
            for (int j = 0; j < 8; ++j) o[64 * j] = x[j];
            norm_mod_store(x, gpre, sc, sh, ((bf16*)(ws + WS_H)) + (size_t)m * DM, lane); }
    }
}
__device__ __forceinline__ s16x4 lds_tr16(LAS unsigned char* p) { return __builtin_bit_cast(s16x4, __builtin_amdgcn_ds_read_tr16_b64_v4i16((LAS s16x4*)p)); }
__device__ __forceinline__ void mixer_a_unit(Ctx& F, int l, int u) {
    unsigned char* const ws = kws();
    float* const out = kout();
    const int lane = opqv(F.lane), h = F.wave;
    const bool samp = u >= 64;
    const int bsel = u >> 4, ci = u & 15;
    const int m0 = samp ? MP + (u - 64) * 128 : bsel * TP + ci * 128;
    const bf16* P = ((bf16*)(ws + WS_PROJ)) + (size_t)m0 * INC;
    LAS float* R = (LAS float*)(F.lds + TAB_OFF);
    LAS float* SSQ = R + 128;
    __syncthreads();
    {
        const float* gv = karg(13) + (size_t)l * WA;
        const bool wr_rows = samp || ci == 15;
        for (int i = 0; i < 16; ++i) {
            const int s = 16 * h + i;
            const bf16* vr = P + (size_t)s * INC + WA;
            const v4u a = *(const v4u*)(vr + 8 * lane), b = *(const v4u*)(vr + 512 + 8 * lane);
            float fa[8], fb[8]; unpack8(a, fa); unpack8(b, fb);
            float ss = 0.f;
#pragma unroll
            for (int j = 0; j < 8; ++j) ss += fa[j] * fa[j] + fb[j] * fb[j];
            const float r = __builtin_amdgcn_rsqf(wave_sum(ss) * (1.0f / WA) + EPS);
            if (lane == 0) R[s] = r;
            if (wr_rows) {
                float* o = samp ? out + O_CVS + ((size_t)(((u - 64) * 16 + (s >> 3)) * NL + l) * TS + (s & 7)) * WA
                                : out + O_CVP + ((size_t)(bsel * NL + l) * 128 + s) * WA;
                const f32x4 g0 = *(const f32x4*)(gv + 8 * lane), g1 = *(const f32x4*)(gv + 8 * lane + 4), g2 = *(const f32x4*)(gv + 512 + 8 * lane), g3 = *(const f32x4*)(gv + 512 + 8 * lane + 4);
                *(f32x4*)(o + 8 * lane) = (f32x4){fa[0], fa[1], fa[2], fa[3]} * r * g0; *(f32x4*)(o + 8 * lane + 4) = (f32x4){fa[4], fa[5], fa[6], fa[7]} * r * g1;
                *(f32x4*)(o + 512 + 8 * lane) = (f32x4){fb[0], fb[1], fb[2], fb[3]} * r * g2; *(f32x4*)(o + 512 + 8 * lane + 4) = (f32x4){fb[4], fb[5], fb[6], fb[7]} * r * g3;
            }
        }
    }
    __syncthreads();
    LAS unsigned char* vt = F.lds + h * 16384;
    const float* Wsp = karg(14) + ((size_t)l * 8 + h) * 128 * 128;
    const float* bsp = karg(15) + (size_t)(l * 8 + h) * 128;
    const float* gvh = karg(13) + (size_t)l * WA + 128 * h;
    const float* gah = karg(17) + (size_t)l * WA + 128 * h;
    const int g = lane >> 4, i16 = lane & 15, q = i16 >> 2, p = i16 & 3;
#pragma unroll 1
    for (int dh = 0; dh < 2; ++dh) {
#pragma unroll
        for (int it = 0; it < 16; ++it) { const int s = it * 8 + (lane >> 3);
            const v4u x = *(const v4u*)(P + (size_t)s * INC + WA + 128 * h + 64 * dh + 8 * (lane & 7));
            *(LAS v4u*)(vt + s * 128 + (lane & 7) * 16) = x; }
        LDS_WAIT(); asm volatile("" ::: "memory");
        bf16x8 vf[4][4];
#pragma unroll
        for (int ks = 0; ks < 4; ++ks)
#pragma unroll
            for (int nt = 0; nt < 4; ++nt) { LAS unsigned char* a = vt + (32 * ks + 8 * g + q) * 128 + (16 * nt + 4 * p) * 2;
                const s16x4 lo = lds_tr16(a), hi = lds_tr16(a + 4 * 128);
                vf[ks][nt] = (bf16x8){lo[0], lo[1], lo[2], lo[3], hi[0], hi[1], hi[2], hi[3]}; }
#pragma unroll 1
        for (int tm = 0; tm < 8; ++tm) {
            const int t = 16 * tm + i16;
            const int tl = samp ? (t & 7) : t;
            const int nks = (tm >> 1) + 1;
            f32x4 acc[4];
#pragma unroll
            for (int nt = 0; nt < 4; ++nt) acc[nt] = (f32x4){0.f, 0.f, 0.f, 0.f};
#pragma unroll
            for (int ks = 0; ks < 4; ++ks) {
                if (ks < nks) {
                    const int s0 = 32 * ks + 8 * g;
                    const int sl0 = samp ? 0 : s0;
                    const bool blk = samp ? ((s0 >> 3) == (t >> 3)) : true;
                    const float* wp = Wsp + (size_t)tl * 128 + sl0;
                    const f32x4 w0 = *(const f32x4*)wp, w1 = *(const f32x4*)(wp + 4);
                    float w[8] = {w0.x, w0.y, w0.z, w0.w, w1.x, w1.y, w1.z, w1.w};
                    const f32x4 r0 = *(const LAS f32x4*)(R + s0), r1 = *(const LAS f32x4*)(R + s0 + 4);
                    const float rr[8] = {r0.x, r0.y, r0.z, r0.w, r1.x, r1.y, r1.z, r1.w};
#pragma unroll
                    for (int j = 0; j < 8; ++j) w[j] = (blk && (sl0 + j <= tl)) ? w[j] * rr[j] : 0.f;
                    v4u ww; ww.x = pk2(w[0], w[1]); ww.y = pk2(w[2], w[3]); ww.z = pk2(w[4], w[5]); ww.w = pk2(w[6], w[7]);
                    const bf16x8 wf = __builtin_bit_cast(bf16x8, ww);
#pragma unroll
                    for (int nt = 0; nt < 4; ++nt) acc[nt] = __builtin_amdgcn_mfma_f32_16x16x32_bf16(vf[ks][nt], wf, acc[nt], 0, 0, 0);
                }
            }
            const float bias = bsp[tl];
            const size_t m = (size_t)m0 + t;
            float ss = 0.f;
#pragma unroll
            for (int nt = 0; nt < 4; ++nt) {
                const int d = 64 * dh + 16 * nt + 4 * g;
                const v2u uw = *(const v2u*)(P + (size_t)t * INC + 128 * h + d);
                const f32x4 uu = (f32x4){bflo(uw.x), bfhi(uw.x), bflo(uw.y), bfhi(uw.y)};
                const f32x4 gv4 = *(const f32x4*)(gvh + d), ga4 = *(const f32x4*)(gah + d);
                const f32x4 o = uu * (acc[nt] * gv4 + bias);
                ss += (o.x * o.x + o.y * o.y) + (o.z * o.z + o.w * o.w);
                const f32x4 og = o * ga4; v2u w2; w2.x = pk2(og.x, og.y); w2.y = pk2(og.z, og.w);
                *(v2u*)(((bf16*)(ws + WS_MRG)) + m * DM + 128 * h + d) = w2;
            }
            ss += __shfl_xor(ss, 16); ss += __shfl_xor(ss, 32);
            if (g == 0) SSQ[(t * 8 + h) * 2 + dh] = ss;
        }
        LDS_WAIT(); asm volatile("" ::: "memory");
    }
    __syncthreads();
    for (int i = 0; i < 16; ++i) {
        const int s = 16 * h + i;
        const LAS f32x4* qq = (const LAS f32x4*)(SSQ + s * 16); const f32x4 q0 = qq[0], q1 = qq[1], q2 = qq[2], q3 = qq[3];
        const float tot = (((q0.x + q0.y) + (q0.z + q0.w)) + ((q1.x + q1.y) + (q1.z + q1.w))) + (((q2.x + q2.y) + (q2.z + q2.w)) + ((q3.x + q3.y) + (q3.z + q3.w)));
        const float ra = __builtin_amdgcn_rsqf(tot * (1.0f / WA) + EPS);
        bf16* row = ((bf16*)(ws + WS_MRG)) + ((size_t)m0 + s) * DM;
        float fa[8], fb[8]; unpack8(*(const v4u*)(row + 8 * lane), fa); unpack8(*(const v4u*)(row + 512 + 8 * lane), fb);
#pragma unroll
        for (int j = 0; j < 8; ++j) { fa[j] *= ra; fb[j] *= ra; }
        *(v4u*)(row + 8 * lane) = pack8(fa); *(v4u*)(row + 512 + 8 * lane) = pack8(fb);
    }
}
__device__ __forceinline__ void load16f(const float* p, int lane, float (&f)[16]) {
    const f32x4 a = *(const f32x4*)(p + 8 * lane), b = *(const f32x4*)(p + 8 * lane + 4), c = *(const f32x4*)(p + 512 + 8 * lane), d = *(const f32x4*)(p + 512 + 8 * lane + 4);
    f[0] = a.x; f[1] = a.y; f[2] = a.z; f[3] = a.w; f[4] = b.x; f[5] = b.y; f[6] = b.z; f[7] = b.w; f[8] = c.x; f[9] = c.y; f[10] = c.z; f[11] = c.w; f[12] = d.x; f[13] = d.y; f[14] = d.z; f[15] = d.w;
}
__device__ __forceinline__ void load16b(const bf16* p, int lane, float (&f)[16]) {
    float a[8], b[8]; unpack8(*(const v4u*)(p + 8 * lane), a); unpack8(*(const v4u*)(p + 512 + 8 * lane), b);
#pragma unroll
    for (int j = 0; j < 8; ++j) { f[j] = a[j]; f[8 + j] = b[j]; }
}
__device__ __forceinline__ void store16f(float* p, int lane, const float (&f)[16]) {
    *(f32x4*)(p + 8 * lane) = (f32x4){f[0], f[1], f[2], f[3]}; *(f32x4*)(p + 8 * lane + 4) = (f32x4){f[4], f[5], f[6], f[7]};
    *(f32x4*)(p + 512 + 8 * lane) = (f32x4){f[8], f[9], f[10], f[11]}; *(f32x4*)(p + 512 + 8 * lane + 4) = (f32x4){f[12], f[13], f[14], f[15]};
}
__device__ __forceinline__ void mixer_b_item(Ctx& F, int l, int seg) {
    unsigned char* const ws = kws();
    float* const out = kout();
    const int lane = opqv(F.lane);
    const int m0 = seg * 8;
    const bool samp = m0 >= MP;
    const int b = samp ? (m0 - MP) >> 3 : m0 >> 11, t0 = samp ? 0 : (m0 & (TP - 1));
    float w0[16], w1[16], w2[16], gb[16], p2[16], p1[16];
    load16f(karg(16) + (size_t)l * 3 * WB, lane, w0); load16f(karg(16) + (size_t)l * 3 * WB + WB, lane, w1); load16f(karg(16) + (size_t)l * 3 * WB + 2 * WB, lane, w2);
    load16f(karg(18) + (size_t)l * WB, lane, gb);
    if (samp) { const float* st = karg(2) + (size_t)(b * NL + l) * 2 * WB; load16f(st, lane, p2); load16f(st + WB, lane, p1); }
    else if (t0 == 0) {
#pragma unroll
        for (int j = 0; j < 16; ++j) { p2[j] = 0.f; p1[j] = 0.f; } }
    else { float a[16], c[16];
        load16b(((bf16*)(ws + WS_PROJ)) + (size_t)(m0 - 2) * INC + 3072, lane, a); load16b(((bf16*)(ws + WS_PROJ)) + (size_t)(m0 - 2) * INC + 4096, lane, c);
#pragma unroll
        for (int j = 0; j < 16; ++j) p2[j] = a[j] * c[j];
        load16b(((bf16*)(ws + WS_PROJ)) + (size_t)(m0 - 1) * INC + 3072, lane, a); load16b(((bf16*)(ws + WS_PROJ)) + (size_t)(m0 - 1) * INC + 4096, lane, c);
#pragma unroll
        for (int j = 0; j < 16; ++j) p1[j] = a[j] * c[j]; }
    const bool tail = samp || (t0 + 8 == TP);
    float* omix = (samp ? out + O_MIXS : out + O_MIXP) + (size_t)(b * NL + l) * 2 * WB;
#pragma unroll
    for (int r = 0; r < 8; ++r) {
        const bf16* pr = ((bf16*)(ws + WS_PROJ)) + (size_t)(m0 + r) * INC;
        float gbv[16], gc[16], hb[16], cin[16], ob[16];
        load16b(pr + 2048, lane, gbv); load16b(pr + 3072, lane, gc); load16b(pr + 4096, lane, hb);
        float ss = 0.f;
#pragma unroll
        for (int j = 0; j < 16; ++j) { cin[j] = gc[j] * hb[j]; ob[j] = gbv[j] * (w0[j] * p2[j] + w1[j] * p1[j] + w2[j] * cin[j]); ss += ob[j] * ob[j]; }
        const float rb = __builtin_amdgcn_rsqf(wave_sum(ss) * (1.0f / WB) + EPS);
        float oa[8], oc[8];
#pragma unroll
        for (int j = 0; j < 8; ++j) { oa[j] = ob[j] * rb * gb[j]; oc[j] = ob[8 + j] * rb * gb[8 + j]; }
        bf16* mr = ((bf16*)(ws + WS_MRG)) + (size_t)(m0 + r) * DM + WA;
        *(v4u*)(mr + 8 * lane) = pack8(oa); *(v4u*)(mr + 512 + 8 * lane) = pack8(oc);
        if (tail && r >= 6) store16f(omix + (size_t)(r - 6) * WB, lane, cin);
#pragma unroll
        for (int j = 0; j < 16; ++j) { p2[j] = p1[j]; p1[j] = cin[j]; }
    }
}
__device__ __forceinline__ void p2_mixer(Ctx& F, int l) {
    constexpr int NA = 72, NBB = (M / 8) / NWAVES;
    for (int u = F.bid; u < NA + NBB; u += F.G) {
        if (u < NA) { MA(mixer_a_unit(F, l, u)); }
        else { MB(mixer_b_item(F, l, (u - NA) * NWAVES + F.wave)); }
    }
}
__device__ __forceinline__ void conv_ffn_item(Ctx& F, int l, int item) {
    unsigned char* const ws = kws();
    float* const out = kout();
    const int lane = opqv(F.lane);
    const int seg = item / 11, cc = item - seg * 11;
    const bool samp = seg >= 512;
    const int b = samp ? seg - 512 : seg >> 7, t0 = samp ? 0 : (seg & 127) * 16, nrows = samp ? 8 : 16;
    const int m0 = samp ? MP + b * 8 : seg * 16;
    const int jg = cc * 512 + 8 * lane, jv = FF + jg;
    const float* wc = karg(21) + (size_t)l * 3 * FF2; const float* bc = karg(22) + (size_t)l * FF2;
    float w0g[8], w1g[8], w2g[8], bg[8], w0v[8], w1v[8], w2v[8], bv[8], g2[8], g1[8], v2[8], v1[8];
#define LD8F(dst, ptr) do { const f32x4 _a = *(const f32x4*)(ptr), _b = *(const f32x4*)((ptr) + 4); dst[0] = _a.x; dst[1] = _a.y; dst[2] = _a.z; dst[3] = _a.w; dst[4] = _b.x; dst[5] = _b.y; dst[6] = _b.z; dst[7] = _b.w; } while (0)
    LD8F(w0g, wc + jg); LD8F(w1g, wc + FF2 + jg); LD8F(w2g, wc + 2 * FF2 + jg); LD8F(bg, bc + jg);
    LD8F(w0v, wc + jv); LD8F(w1v, wc + FF2 + jv); LD8F(w2v, wc + 2 * FF2 + jv); LD8F(bv, bc + jv);
    if (samp) { const float* st = karg(3) + (size_t)(b * NL + l) * 2 * FF2; LD8F(g2, st + jg); LD8F(v2, st + jv); LD8F(g1, st + FF2 + jg); LD8F(v1, st + FF2 + jv); }
    else if (t0 == 0) {
#pragma unroll
        for (int j = 0; j < 8; ++j) { g2[j] = 0.f; g1[j] = 0.f; v2[j] = 0.f; v1[j] = 0.f; } }
    else { unpack8(*(const v4u*)(((bf16*)(ws + WS_UP)) + (size_t)(m0 - 2) * FF2 + jg), g2); unpack8(*(const v4u*)(((bf16*)(ws + WS_UP)) + (size_t)(m0 - 2) * FF2 + jv), v2);
           unpack8(*(const v4u*)(((bf16*)(ws + WS_UP)) + (size_t)(m0 - 1) * FF2 + jg), g1); unpack8(*(const v4u*)(((bf16*)(ws + WS_UP)) + (size_t)(m0 - 1) * FF2 + jv), v1); }
    const bool tail = samp || (t0 + 16 == TP);
    float* offn = (samp ? out + O_FFNS : out + O_FFNP) + (size_t)(b * NL + l) * 2 * FF2;
#pragma unroll 8
    for (int r = 0; r < nrows; ++r) {
        float xg[8], xv[8], a[8];
        unpack8(*(const v4u*)(((bf16*)(ws + WS_UP)) + (size_t)(m0 + r) * FF2 + jg), xg); unpack8(*(const v4u*)(((bf16*)(ws + WS_UP)) + (size_t)(m0 + r) * FF2 + jv), xv);
#pragma unroll
        for (int j = 0; j < 8; ++j) { const float G = w0g[j] * g2[j] + w1g[j] * g1[j] + w2g[j] * xg[j] + bg[j], V = w0v[j] * v2[j] + w1v[j] * v1[j] + w2v[j] * xv[j] + bv[j]; a[j] = silu_f(G) * V; }
        *(v4u*)(((bf16*)(ws + WS_ACT)) + (size_t)(m0 + r) * FF + jg) = pack8(a);
        if (tail && r >= nrows - 2) { float* o = offn + (size_t)(r - (nrows - 2)) * FF2;
            *(f32x4*)(o + jg) = (f32x4){xg[0], xg[1], xg[2], xg[3]}; *(f32x4*)(o + jg + 4) = (f32x4){xg[4], xg[5], xg[6], xg[7]};
            *(f32x4*)(o + jv) = (f32x4){xv[0], xv[1], xv[2], xv[3]}; *(f32x4*)(o + jv + 4) = (f32x4){xv[4], xv[5], xv[6], xv[7]}; }
#pragma unroll
        for (int j = 0; j < 8; ++j) { g2[j] = g1[j]; g1[j] = xg[j]; v2[j] = v1[j]; v1[j] = xv[j]; }
    }
#undef LD8F
}
__device__ __forceinline__ void p6_conv_ffn(Ctx& F, int l) {
    const int gw = F.bid * NWAVES + F.wave, NGW = F.G * NWAVES;
    constexpr int NITEMS = (512 + NS) * 11;
    for (int it = gw; it < NITEMS; it += NGW) conv_ffn_item(F, l, it);
}

__device__ __forceinline__ int opq(int v) { asm volatile("" : "+s"(v)); return v; }
struct Args { const float* in[24]; float* out; unsigned char* ws; int ph_lo, ph_hi; };
__global__ void __launch_bounds__(NTHREADS, 2) fwd(Args args) {
    extern __shared__ __attribute__((aligned(16))) unsigned char lds_raw[];
    Ctx F;
    F.lds = (LAS unsigned char*)lds_raw;
    volatile LAS unsigned* MISC = (volatile LAS unsigned*)(F.lds + MISC_OFF);
    F.tid = threadIdx.x; F.lane = F.tid & 63; F.wave = __builtin_amdgcn_readfirstlane(F.tid >> 6);
    F.G = gridDim.x; F.bid = blockIdx.x;
    gu32* ctl = (gu32*)(args.ws + WS_CTL);
    for (int u = F.tid; u < (LDS_BYTES - MISC_OFF) / 4; u += NTHREADS) ((LAS unsigned*)(F.lds + MISC_OFF))[u] = 0u;
    __syncthreads();
#if MK_PER_PHASE
#define SEAM(k) do { } while (0)
#else
    XcdBarrier bar = xcd_barrier_post((unsigned*)(ctl + CW_BAR), MISC + 8);
#define SEAM(k) do { if (lo <= (k) && (k) + 1 < hi) xcd_barrier(bar); } while (0)
#endif
    const int lo = args.ph_lo, hi = args.ph_hi;
#define IN(k) (lo <= (k) && (k) < hi)
    if (IN(0)) { T0(p0a_prologue(F)); }
    SEAM(0);
    if (IN(1)) {
        pg8::Gemm g{((bf16*)(kws() + WS_SC)), ((bf16*)(kws() + WS_WADA)), 256, NMODALL, DM}; pg8::StaticOrder S; S.init(256, NMODALL, DM, F.G, opq(F.bid));
        pg8::EpiF32 E{((float*)(kws() + WS_MOD)), NMODALL, karg(7), nullptr};
        GG0(pg8::gemm_phase<pg8::EpiF32, pg8::StaticOrder, true, true>(F.lds, g, S, E);)
    }
    SEAM(1);
    if (IN(2)) { T1(p0c_h0(F)); }
    SEAM(2);
#pragma unroll 1
    for (int l = 0; l < NL; ++l) {
        const int pb = 3 + 8 * l;
        if (IN(pb + 0)) {
            pg8::Gemm g{((bf16*)(kws() + WS_H)), ((bf16*)(kws() + WS_WIN)) + (size_t)l * INC * DM, M, INC, DM}; pg8::StaticOrder S; S.init(M, INC, DM, F.G, opq(F.bid));
            pg8::EpiBf16G E{((bf16*)(kws() + WS_PROJ)), INC, 8};
            GG1(pg8::gemm_phase<pg8::EpiBf16G, pg8::StaticOrder, true, true>(F.lds, g, S, E);)
        }
        SEAM(pb + 0);
        if (IN(pb + 1)) { T2(p2_mixer(F, l)); }
        SEAM(pb + 1);
        if (IN(pb + 2)) {
            pg8::Gemm g{((bf16*)(kws() + WS_MRG)), ((bf16*)(kws() + WS_WOUT)) + (size_t)l * DM * DM, M, DM, DM}; pg8::SplitOrder S; S.init(DM, F.G, opq(F.bid));
            pg8::EpiF32 E{((float*)(kws() + WS_Y)), DM, nullptr, ((float*)(kws() + WS_PART))};
            GG2(pg8::gemm_phase<pg8::EpiF32, pg8::SplitOrder, true, true>(F.lds, g, S, E);)
        }
        SEAM(pb + 2);
        if (IN(pb + 3)) { T3(row_update<true>(F, l)); }
        SEAM(pb + 3);
        if (IN(pb + 4)) {
            pg8::Gemm g{((bf16*)(kws() + WS_H)), ((bf16*)(kws() + WS_WUP)) + (size_t)l * FF2 * DM, M, FF2, DM}; pg8::StaticOrder S; S.init(M, FF2, DM, F.G, opq(F.bid));
            pg8::EpiBf16G E{((bf16*)(kws() + WS_UP)), FF2, 0};
            GG3(pg8::gemm_phase<pg8::EpiBf16G, pg8::StaticOrder, true, true>(F.lds, g, S, E);)
        }
        SEAM(pb + 4);
        if (IN(pb + 5)) { T4(p6_conv_ffn(F, l)); }
        SEAM(pb + 5);
        if (IN(pb + 6)) {
            pg8::Gemm g{((bf16*)(kws() + WS_ACT)), ((bf16*)(kws() + WS_WDN)) + (size_t)l * DM * FF, M, DM, FF}; pg8::SplitOrder S; S.init(FF, F.G, opq(F.bid));
            pg8::EpiF32 E{((float*)(kws() + WS_Y)), DM, nullptr, ((float*)(kws() + WS_PART))};
            GG4(pg8::gemm_phase<pg8::EpiF32, pg8::SplitOrder, true, true>(F.lds, g, S, E);)
        }
        SEAM(pb + 6);
        if (IN(pb + 7)) { T5(row_update<false>(F, l)); }
        SEAM(pb + 7);
    }
#undef IN
#undef SEAM
}

extern "C" void kernel_launch(void* const* d_in, const int* in_sizes, int n_in, void* d_out, int out_size, void* d_ws, size_t ws_size, hipStream_t stream) {
    static int grid = 0;
    if (grid == 0) {
        if (n_in != 24 || in_sizes[0] != MP * DM || (size_t)out_size != O_END || ws_size < WS_END) {
            fprintf(stderr, "kernel_launch: unexpected shapes (n_in %d, in0 %d, out %d, ws %zu); nothing launched\n", n_in, n_in > 0 ? in_sizes[0] : -1, out_size, ws_size); grid = -1; return; }
        int dev = 0, cus = 0, per_cu = 0;
        if (hipGetDevice(&dev) != hipSuccess || hipDeviceGetAttribute(&cus, hipDeviceAttributeMultiprocessorCount, dev) != hipSuccess) { grid = -1; return; }
        if (hipFuncSetAttribute((const void*)fwd, hipFuncAttributeMaxDynamicSharedMemorySize, LDS_BYTES) != hipSuccess) { fprintf(stderr, "kernel_launch: hipFuncSetAttribute failed\n"); grid = -1; return; }
        if (hipOccupancyMaxActiveBlocksPerMultiprocessor(&per_cu, (const void*)fwd, NTHREADS, LDS_BYTES) != hipSuccess || per_cu < 1) { fprintf(stderr, "kernel_launch: occupancy query says %d blocks per CU\n", per_cu); }
        (void)hipGetLastError();
        grid = cus;
    }
    if (grid < 0) return;
    if (hipMemsetAsync((char*)d_ws + WS_CTL, 0, CTL_ZERO_BYTES, stream) != hipSuccess) return;
    Args a{};
    for (int i = 0; i < 24; ++i) a.in[i] = (const float*)d_in[i];
    a.out = (float*)d_out; a.ws = (unsigned char*)d_ws;
#if MK_PER_PHASE
    for (int p = 0; p < NPHASES; ++p) { a.ph_lo = p; a.ph_hi = p + 1; hipLaunchKernelGGL(fwd, dim3(grid), dim3(NTHREADS), LDS_BYTES, stream, a); }
#else
    a.ph_lo = 0; a.ph_hi = NPHASES;
    hipLaunchKernelGGL(fwd, dim3(grid), dim3(NTHREADS), LDS_BYTES, stream, a);
#endif
    const hipError_t le = hipPeekAtLastError();
    if (le != hipSuccess) fprintf(stderr, "kernel_launch: launch failed: %s\n", hipGetErrorName(le));
}
```

```cpp
#include <hip/hip_runtime.h>
#include <cstdio>
#include <cstdint>
#ifndef MK_PER_PHASE
#define MK_PER_PHASE 0
#endif
#ifndef REP_GEMM
#define REP_GEMM 1
#endif
#ifndef REP_PRO
#define REP_PRO 1
#endif
#ifndef REP_MIX
#define REP_MIX 1
#endif
#ifndef REP_CONV
#define REP_CONV 1
#endif
#ifndef REP_ROW
#define REP_ROW 1
#endif
#ifndef REP_BAR
#define REP_BAR 1
#endif
#define GG0(...) for (int _r = 0; _r < REP_GEMM; ++_r) { __VA_ARGS__ }
#define GG1(...) for (int _r = 0; _r < REP_GEMM; ++_r) { __VA_ARGS__ }
#define GG2(...) for (int _r = 0; _r < REP_GEMM; ++_r) { __VA_ARGS__ }
#define GG3(...) for (int _r = 0; _r < REP_GEMM; ++_r) { __VA_ARGS__ }
#define GG4(...) for (int _r = 0; _r < REP_GEMM; ++_r) { __VA_ARGS__ }
#define T0(...) for (int _r = 0; _r < REP_PRO; ++_r) { __VA_ARGS__; }
#define T1(...) __VA_ARGS__
#define T2(...) for (int _r = 0; _r < REP_MIX; ++_r) { __VA_ARGS__; }
#define T3(...) __VA_ARGS__
#define T4(...) for (int _r = 0; _r < REP_CONV; ++_r) { __VA_ARGS__; }
#define T5(...) __VA_ARGS__
#define MA(...) __VA_ARGS__
#define MB(...) __VA_ARGS__
namespace pg8 {
#define PG8_LAS __attribute__((address_space(3)))
typedef unsigned short bf16_t;
typedef short bf16x8 __attribute__((ext_vector_type(8)));
typedef float f32x4 __attribute__((ext_vector_type(4)));
typedef unsigned u32x4 __attribute__((ext_vector_type(4)));
constexpr int BM = 256, BK = 64, HALF = 128, HTB = HALF * BK * 2  , STAGE_BYTES = 8 * HTB, NXCD = 8, WGM = 8;

__host__ __device__ __forceinline__ int lds_byte(int r, int c) { const int st = (r >> 4) * 2 + (c >> 5), rr = r & 15, cc = c & 31, ob = rr * 64 + cc * 2; return st * 1024 + (ob ^ (((ob >> 9) & 1) << 5)); }
__host__ __device__ __forceinline__ void stage_rc(int b, int& R, int& C) { const int st = b / 1024, sb = b % 1024, swz = sb ^ (((sb >> 9) & 1) << 5); R = (st >> 1) * 16 + swz / 64; C = (st & 1) * 32 + (swz % 64) / 2; }
__host__ __device__ __forceinline__ int perm32(int rho) { const int n = rho >> 4, i = rho & 15; return 8 * (i >> 2) + 4 * n + (i & 3); }

struct Unit { int pm, pn, ks; };
struct Gemm { const bf16_t* A; const bf16_t* Bt; int M, N, K; };

struct StaticOrder {
    int nM, nN, nwg, G, c, KT;
    __host__ __device__ void init(int M, int N, int K, int G_, int c_) { nM = M / BM; nN = N / BM; nwg = nM * nN; G = G_; c = c_; KT = K / BK; }
    __host__ __device__ bool next(int i, Unit& u) const {
        const long L = (long)i * G + c; if (L >= nwg) return false;
        int wgid = (int)L; { const int q = nwg / NXCD, r = nwg % NXCD, xcd = wgid % NXCD, off = wgid / NXCD; wgid = (xcd < r ? xcd * (q + 1) : r * (q + 1) + (xcd - r) * q) + off; }
        const int nig = WGM * nN, gid = wgid / nig, fm = gid * WGM, gsz = (nM - fm) < WGM ? (nM - fm) : WGM;
        u.pm = fm + ((wgid % nig) % gsz); u.pn = (wgid % nig) / gsz; u.ks = -1; return true;
    }
    __device__ __forceinline__ int k0(const Unit&) const { return 0; }
    __device__ __forceinline__ int nt(const Unit&) const { return KT; }
    __device__ __forceinline__ void a_ready(const Unit&) const {}
    __device__ __forceinline__ void done(const Unit&) const {}
};
struct SplitOrder {
    int G, c, KB;
    __host__ __device__ void init(int K, int G_, int c_) { G = G_; c = c_; KB = K / 128; }
    __host__ __device__ bool next(int i, Unit& u) const {
        const int L = i * G + c; if (L >= 512) return false;
        if (L < 256) { const int x = L & 7, j = L >> 3; u.pm = 4 * x + (j >> 3); u.pn = j & 7; u.ks = -1; }
        else { const int Ls = L - 256, j = Ls >> 3; u.pm = 32 + (j >> 3); u.pn = j & 7; u.ks = Ls & 7; }
        return true;
    }
    __device__ __forceinline__ int k0(const Unit& u) const { const int base = KB >> 3, rem = KB & 7; return u.ks < 0 ? 0 : 128 * (u.ks * base + (u.ks < rem ? u.ks : rem)); }
    __device__ __forceinline__ int nt(const Unit& u) const { const int base = KB >> 3, rem = KB & 7; return u.ks < 0 ? 2 * KB : 2 * (base + (u.ks < rem ? 1 : 0)); }
    __device__ __forceinline__ void a_ready(const Unit&) const {}
    __device__ __forceinline__ void done(const Unit&) const {}
};

__device__ __forceinline__ unsigned cvt_pk_bf16(float lo, float hi) { unsigned r; asm volatile("v_cvt_pk_bf16_f32 %0, %1, %2" : "=v"(r) : "v"(lo), "v"(hi)); return r; }
typedef float f32x2 __attribute__((ext_vector_type(2)));
__device__ __forceinline__ float gelu_tanh(float x) {
    const float z = x * (1.5957691216f + 0.0713548163f * x * x);
    const float e = __builtin_amdgcn_exp2f(-1.4426950409f * z);
    return x * __builtin_amdgcn_rcpf(1.0f + e);
}
struct EpiBf16G {
    static constexpr bool PERM = true, AFTER_DRAIN = false;
    bf16_t* O; int ldc; int ngelu;
    __device__ __forceinline__ void operator()(const f32x4 (&acc)[2][2][4][2], const Unit& u, int wr, int wc, int fr, int fq) const {
        const int row0 = u.pm * BM + wr * 64 + fr; const int col0 = u.pn * BM + wc * 32 + 8 * fq;
        const bool act = u.pn < ngelu;
#pragma unroll
        for (int ai = 0; ai < 2; ++ai)
#pragma unroll
            for (int m = 0; m < 4; ++m) { bf16_t* rowp = O + (size_t)(row0 + ai * HALF + m * 16) * ldc + col0;
#pragma unroll
                for (int bj = 0; bj < 2; ++bj) { f32x4 v0 = acc[ai][bj][m][0], v1 = acc[ai][bj][m][1];
                    if (act) {
#pragma unroll
                        for (int j = 0; j < 4; ++j) { v0[j] = gelu_tanh(v0[j]); v1[j] = gelu_tanh(v1[j]); } }
                    u32x4 w; w.x = cvt_pk_bf16(v0[0], v0[1]); w.y = cvt_pk_bf16(v0[2], v0[3]); w.z = cvt_pk_bf16(v1[0], v1[1]); w.w = cvt_pk_bf16(v1[2], v1[3]);
                    *(u32x4*)(rowp + bj * HALF) = w; } }
    }
};
struct EpiF32 {
    static constexpr bool PERM = false, AFTER_DRAIN = false;
    float* C; int ldc; const float* bias; float* Cpart;
    __device__ __forceinline__ void operator()(const f32x4 (&acc)[2][2][4][2], const Unit& u, int wr, int wc, int fr, int fq) const {
        const int row0 = u.pm * BM + wr * 64 + fr, col0 = u.pn * BM + wc * 32 + 4 * fq;
        float* Cb = u.ks < 0 ? C : Cpart + (ptrdiff_t)(u.ks * 1024 - 32 * BM) * ldc;
        f32x4 bv[2][2];
#pragma unroll
        for (int bj = 0; bj < 2; ++bj)
#pragma unroll
            for (int n = 0; n < 2; ++n) bv[bj][n] = bias ? *(const f32x4*)(bias + col0 + bj * HALF + n * 16) : (f32x4){0.f, 0.f, 0.f, 0.f};
#pragma unroll
        for (int ai = 0; ai < 2; ++ai)
#pragma unroll
            for (int m = 0; m < 4; ++m) { float* rowp = Cb + (size_t)(row0 + ai * HALF + m * 16) * ldc + col0;
#pragma unroll
                for (int bj = 0; bj < 2; ++bj)
#pragma unroll
                    for (int n = 0; n < 2; ++n) *(f32x4*)(rowp + bj * HALF + n * 16) = acc[ai][bj][m][n] + bv[bj][n]; }
    }
};
struct EpiY {
    static constexpr bool PERM = true, AFTER_DRAIN = false;
    bf16_t* Y; float* Cpart; int ldc;
    __device__ __forceinline__ void operator()(const f32x4 (&acc)[2][2][4][2], const Unit& u, int wr, int wc, int fr, int fq) const {
        const int row0 = u.pm * BM + wr * 64 + fr; const int col0 = u.pn * BM + wc * 32 + 8 * fq;
        if (u.ks < 0) {
#pragma unroll
            for (int ai = 0; ai < 2; ++ai)
#pragma unroll
                for (int m = 0; m < 4; ++m) { bf16_t* rowp = Y + (size_t)(row0 + ai * HALF + m * 16) * ldc + col0;
#pragma unroll
                    for (int bj = 0; bj < 2; ++bj) { const f32x4 v0 = acc[ai][bj][m][0], v1 = acc[ai][bj][m][1];
                        u32x4 w; w.x = cvt_pk_bf16(v0[0], v0[1]); w.y = cvt_pk_bf16(v0[2], v0[3]); w.z = cvt_pk_bf16(v1[0], v1[1]); w.w = cvt_pk_bf16(v1[2], v1[3]);
                        *(u32x4*)(rowp + bj * HALF) = w; } }
        } else {
            float* Cb = Cpart + (ptrdiff_t)(u.ks * 1024 - 32 * BM) * ldc;
#pragma unroll
            for (int ai = 0; ai < 2; ++ai)
#pragma unroll
                for (int m = 0; m < 4; ++m) { float* rowp = Cb + (size_t)(row0 + ai * HALF + m * 16) * ldc + col0;
#pragma unroll
                    for (int bj = 0; bj < 2; ++bj) { *(f32x4*)(rowp + bj * HALF) = acc[ai][bj][m][0]; *(f32x4*)(rowp + bj * HALF + 4) = acc[ai][bj][m][1]; } }
        }
    }
};
template <class Epi, class Sched, bool ALIGN_EPI = false, bool SP2 = false>
__device__ __forceinline__ void gemm_phase(PG8_LAS unsigned char* lds, const Gemm g, const Sched& S, const Epi& E) {
    int tid_ = threadIdx.x; asm volatile("" : "+v"(tid_));
    const int tid = tid_, wid = __builtin_amdgcn_readfirstlane(tid >> 6), lane = tid & 63, wr = wid >> 2, wc = wid & 3, fr = lane & 15, fq = lane >> 4;
    const int K = g.K;
    unsigned voffA[2], voffB[2];
#pragma unroll
    for (int i = 0; i < 2; ++i) { int R, C; stage_rc(tid * 16 + i * 8192, R, C); const int Rb = Epi::PERM ? ((R & ~31) + perm32(R & 31)) : R;
        voffA[i] = (unsigned)(R * K + C) * 2u; voffB[i] = (unsigned)(Rb * K + C) * 2u; }
    const size_t kstep = (size_t)(BK * 2);
    const size_t hstep = (size_t)HALF * K * 2;
    const size_t tstep = 2 * hstep;
    const unsigned ldsw = (unsigned)wid * 1024u;
    const int aoff = lds_byte(wr * 64 + fr, fq * 8), boff = lds_byte(wc * 32 + fr, fq * 8);
#define PG8_SA(b, h) (((b) * 2 + (h)) * HTB)
#define PG8_SB(b, h) ((4 + (b) * 2 + (h)) * HTB)
#define PG8_STAGE(bufoff, gbase, voff) do { _Pragma("unroll") for (int _i = 0; _i < 2; ++_i) \
        __builtin_amdgcn_global_load_lds((const unsigned*)((const char*)(gbase) + (voff)[_i]), (PG8_LAS unsigned*)(lds + (bufoff) + ldsw + _i * 8192), 16, 0, 0); } while (0)
#define PG8_LDA(dst, b, h) do { _Pragma("unroll") for (int m = 0; m < 4; ++m) _Pragma("unroll") for (int k = 0; k < 2; ++k) dst[m][k] = *(const PG8_LAS bf16x8*)(lds + PG8_SA(b, h) + aoff + m * 2048 + k * 1024); } while (0)
#define PG8_LDB(dst, b, h) do { _Pragma("unroll") for (int n = 0; n < 2; ++n) _Pragma("unroll") for (int k = 0; k < 2; ++k) dst[n][k] = *(const PG8_LAS bf16x8*)(lds + PG8_SB(b, h) + boff + n * 2048 + k * 1024); } while (0)
#define PG8_MMA(ai, bj, At, Bt) do { __builtin_amdgcn_s_setprio(1); _Pragma("unroll") for (int m = 0; m < 4; ++m) _Pragma("unroll") for (int n = 0; n < 2; ++n) _Pragma("unroll") for (int k = 0; k < 2; ++k) \
        acc[ai][bj][m][n] = __builtin_amdgcn_mfma_f32_16x16x32_bf16(Bt[n][k], At[m][k], acc[ai][bj][m][n], 0, 0, 0); __builtin_amdgcn_s_setprio(0); } while (0)
#define PG8_WAIT_V(n) asm volatile("s_waitcnt vmcnt(" #n ")" ::: "memory")
#define PG8_WAIT_L(n) asm volatile("s_waitcnt lgkmcnt(" #n ")" ::: "memory")
#define PG8_BAR __builtin_amdgcn_s_barrier()
#define PG8_SCHED __builtin_amdgcn_sched_barrier(0)
    Unit cur, nxt; int ui = 0;
    if (!S.next(0, cur)) return;
    f32x4 acc[2][2][4][2];
#pragma unroll
    for (int a = 0; a < 2; ++a)
#pragma unroll
        for (int b = 0; b < 2; ++b)
#pragma unroll
            for (int m = 0; m < 4; ++m)
#pragma unroll
                for (int n = 0; n < 2; ++n) acc[a][b][m][n] = (f32x4){0.f, 0.f, 0.f, 0.f};
    bf16x8 At[4][2], B0[2][2], B1[2][2];
    const char* cA = (const char*)g.A + (size_t)cur.pm * tstep + (size_t)S.k0(cur) * 2; const char* cB = (const char*)g.Bt + (size_t)cur.pn * tstep + (size_t)S.k0(cur) * 2;
    S.a_ready(cur);
    if constexpr (SP2) {
        PG8_STAGE(PG8_SB(0, 0), cB, voffB); PG8_STAGE(PG8_SB(0, 1), cB + hstep, voffB); PG8_STAGE(PG8_SA(0, 0), cA, voffA); PG8_STAGE(PG8_SA(0, 1), cA + hstep, voffA);
        if (wr == 1) PG8_BAR;
        PG8_WAIT_V(2); PG8_BAR;
        PG8_STAGE(PG8_SB(1, 0), cB + kstep, voffB); PG8_STAGE(PG8_SA(1, 0), cA + kstep, voffA); PG8_STAGE(PG8_SB(1, 1), cB + hstep + kstep, voffB);
        PG8_WAIT_V(6); PG8_BAR;
    } else {
        PG8_STAGE(PG8_SB(0, 0), cB, voffB); PG8_STAGE(PG8_SA(0, 0), cA, voffA); PG8_STAGE(PG8_SB(0, 1), cB + hstep, voffB); PG8_STAGE(PG8_SA(0, 1), cA + hstep, voffA);
        if (wr == 1) PG8_BAR;
        PG8_WAIT_V(4); PG8_BAR;
        PG8_STAGE(PG8_SB(1, 0), cB + kstep, voffB); PG8_STAGE(PG8_SA(1, 0), cA + kstep, voffA); PG8_STAGE(PG8_SB(1, 1), cB + hstep + kstep, voffB);
        PG8_WAIT_V(6); PG8_BAR;
    }
    for (;;) {
        const bool has_next = S.next(ui + 1, nxt);
        const char* nA = has_next ? (const char*)g.A + (size_t)nxt.pm * tstep + (size_t)S.k0(nxt) * 2 : cA; const char* nB = has_next ? (const char*)g.Bt + (size_t)nxt.pn * tstep + (size_t)S.k0(nxt) * 2 : cB;
        const int nt = S.nt(cur);
        for (int t = 0; t < nt; t += 2) {
            const bool last = (t == nt - 2);
            const char* a1 = cA + (size_t)(t + 1) * kstep;
            const char* a2 = last ? nA : cA + (size_t)(t + 2) * kstep; const char* b2 = last ? nB : cB + (size_t)(t + 2) * kstep;
            const char* a3 = a2 + kstep; const char* b3 = b2 + kstep;
            if (last && has_next) S.a_ready(nxt);
            if constexpr (SP2) {
            PG8_LDB(B0, 0, 0); PG8_LDB(B1, 0, 1); PG8_SCHED; PG8_LDA(At, 0, 0); PG8_STAGE(PG8_SA(1, 1), a1 + hstep, voffA);
            PG8_WAIT_V(8); PG8_WAIT_L(0); PG8_BAR; PG8_MMA(0, 0, At, B0); PG8_MMA(0, 1, At, B1); PG8_BAR; PG8_SCHED;
            PG8_LDA(At, 0, 1); PG8_STAGE(PG8_SB(0, 0), b2, voffB); PG8_STAGE(PG8_SB(0, 1), b2 + hstep, voffB); PG8_STAGE(PG8_SA(0, 0), a2, voffA);
            PG8_WAIT_V(8); PG8_WAIT_L(0); PG8_BAR; PG8_MMA(1, 0, At, B0); PG8_MMA(1, 1, At, B1); PG8_BAR; PG8_SCHED;
            PG8_LDB(B0, 1, 0); PG8_LDB(B1, 1, 1); PG8_SCHED; PG8_LDA(At, 1, 0); PG8_STAGE(PG8_SA(0, 1), a2 + hstep, voffA);
            PG8_WAIT_V(8); PG8_WAIT_L(0); PG8_BAR; PG8_MMA(0, 0, At, B0); PG8_MMA(0, 1, At, B1); PG8_BAR; PG8_SCHED;
            PG8_LDA(At, 1, 1); PG8_STAGE(PG8_SB(1, 0), b3, voffB); PG8_STAGE(PG8_SB(1, 1), b3 + hstep, voffB); PG8_STAGE(PG8_SA(1, 0), a3, voffA);
            PG8_WAIT_V(8); PG8_WAIT_L(0); PG8_BAR; PG8_MMA(1, 0, At, B0); PG8_MMA(1, 1, At, B1); PG8_BAR; PG8_SCHED;
            } else {
            PG8_LDB(B0, 0, 0); PG8_SCHED; PG8_LDA(At, 0, 0); PG8_STAGE(PG8_SA(1, 1), a1 + hstep, voffA);
            PG8_WAIT_L(8); PG8_BAR; PG8_WAIT_L(0); PG8_MMA(0, 0, At, B0); PG8_BAR; PG8_SCHED;
            PG8_LDB(B1, 0, 1); PG8_STAGE(PG8_SB(0, 0), b2, voffB);
            PG8_BAR; PG8_WAIT_L(0); PG8_MMA(0, 1, At, B1); PG8_BAR;
            PG8_LDA(At, 0, 1); PG8_STAGE(PG8_SA(0, 0), a2, voffA);
            PG8_BAR; PG8_WAIT_L(0); PG8_MMA(1, 0, At, B0); PG8_BAR; PG8_SCHED;
            PG8_STAGE(PG8_SB(0, 1), b2 + hstep, voffB);
            PG8_WAIT_V(6); PG8_BAR; PG8_MMA(1, 1, At, B1); PG8_BAR;
            PG8_LDB(B0, 1, 0); PG8_SCHED; PG8_LDA(At, 1, 0); PG8_STAGE(PG8_SA(0, 1), a2 + hstep, voffA);
            PG8_WAIT_L(8); PG8_BAR; PG8_WAIT_L(0); PG8_MMA(0, 0, At, B0); PG8_BAR; PG8_SCHED;
            PG8_LDB(B1, 1, 1); PG8_STAGE(PG8_SB(1, 0), b3, voffB);
            PG8_BAR; PG8_WAIT_L(0); PG8_MMA(0, 1, At, B1); PG8_BAR;
            PG8_LDA(At, 1, 1); PG8_STAGE(PG8_SA(1, 0), a3, voffA);
            PG8_BAR; PG8_WAIT_L(0); PG8_MMA(1, 0, At, B0); PG8_BAR; PG8_SCHED;
            PG8_STAGE(PG8_SB(1, 1), b3 + hstep, voffB);
            PG8_WAIT_V(6); PG8_BAR; PG8_MMA(1, 1, At, B1); PG8_BAR;
            }
        }
        if constexpr (ALIGN_EPI) { if (wr == 0) PG8_BAR; }
        if constexpr (!Epi::AFTER_DRAIN) { E(acc, cur, wr, wc, fr, fq); S.done(cur); }
        if (!has_next) break;
#pragma unroll
        for (int a = 0; a < 2; ++a)
#pragma unroll
            for (int b = 0; b < 2; ++b)
#pragma unroll
                for (int m = 0; m < 4; ++m)
#pragma unroll
                    for (int n = 0; n < 2; ++n) acc[a][b][m][n] = (f32x4){0.f, 0.f, 0.f, 0.f};
        cur = nxt; cA = nA; cB = nB; ++ui;
        if constexpr (ALIGN_EPI) { if (wr == 1) PG8_BAR; }
    }
    PG8_WAIT_V(0);
    if constexpr (!ALIGN_EPI) { if (wr == 0) PG8_BAR; }
    PG8_BAR;
    if constexpr (Epi::AFTER_DRAIN) { E.fused(acc, cur, wr, wc, fr, fq, lds, wid, lane); S.done(cur); }
#undef PG8_SA
#undef PG8_SB
#undef PG8_STAGE
#undef PG8_LDA
#undef PG8_LDB
#undef PG8_MMA
#undef PG8_WAIT_V
#undef PG8_WAIT_L
#undef PG8_BAR
#undef PG8_SCHED
}
}

constexpr int DM = 2048, NP = 4, TP = 2048, NL = 4, NS = 128, TS = 8;
constexpr int MP = NP * TP, MS = NS * TS, M = MP + MS;
constexpr int WA = 1024, WB = 1024, INC = 5120, FF = 5632, FF2 = 2 * FF, NMOD = 6 * DM, NMODALL = NL * NMOD;
constexpr int NSEQ = NP + NS;
constexpr float EPS = 1e-6f;
constexpr size_t O_YP = 0, O_YS = O_YP + (size_t)MP * DM, O_MIXP = O_YS + (size_t)MS * DM, O_MIXS = O_MIXP + (size_t)NP * NL * 2 * WB,
                 O_FFNP = O_MIXS + (size_t)NS * NL * 2 * WB, O_FFNS = O_FFNP + (size_t)NP * NL * 2 * FF2, O_CVP = O_FFNS + (size_t)NS * NL * 2 * FF2,
                 O_CVS = O_CVP + (size_t)NP * NL * 128 * WA, O_END = O_CVS + (size_t)NS * NL * TS * WA;
static_assert(O_END == 38141952, "output size");
constexpr size_t MiB = 1u << 20;
constexpr size_t WS_CTL = 0, CTL_ZERO_BYTES = 1 * MiB;
constexpr size_t WS_SC = 1 * MiB;
constexpr size_t WS_MOD = 2 * MiB;
constexpr size_t WS_WIN = 50 * MiB, WS_WOUT = 130 * MiB, WS_WUP = 162 * MiB, WS_WDN = 338 * MiB, WS_WADA = 426 * MiB;
constexpr size_t WS_X = 618 * MiB, WS_H = 690 * MiB, WS_PROJ = 726 * MiB, WS_MRG = 816 * MiB, WS_YB = 852 * MiB, WS_UP = 924 * MiB, WS_ACT = 1122 * MiB, WS_PART = 1221 * MiB, WS_END = 1285 * MiB;
static_assert(WS_MOD + (size_t)256 * NMODALL * 4 <= WS_WIN && WS_WIN + (size_t)NL * INC * DM * 2 <= WS_WOUT && WS_WOUT + (size_t)NL * DM * DM * 2 <= WS_WUP &&
              WS_WUP + (size_t)NL * FF2 * DM * 2 <= WS_WDN && WS_WDN + (size_t)NL * DM * FF * 2 <= WS_WADA && WS_WADA + (size_t)NMODALL * DM * 2 <= WS_X &&
              WS_X + (size_t)M * DM * 4 <= WS_H && WS_H + (size_t)M * DM * 2 <= WS_PROJ && WS_PROJ + (size_t)M * INC * 2 <= WS_MRG && WS_MRG + (size_t)M * DM * 2 <= WS_YB &&
              WS_YB + (size_t)M * DM * 2 <= WS_UP && WS_UP + (size_t)M * FF2 * 2 <= WS_ACT && WS_ACT + (size_t)M * FF * 2 <= WS_PART && WS_PART + (size_t)8 * MS * DM * 4 <= WS_END, "d_ws map");
constexpr int CW_BAR = 4096;
constexpr int RING_BYTES = 131072;
constexpr int MISC_OFF = RING_BYTES;
constexpr int TAB_OFF = RING_BYTES + 1024;
constexpr int LDS_BYTES = 147456;
constexpr int NWAVES = 8, NTHREADS = 512;
constexpr int NPHASES = 3 + 8 * NL;

#define GAS __attribute__((address_space(1)))
#define LAS __attribute__((address_space(3)))
typedef unsigned short bf16;
typedef unsigned v4u __attribute__((ext_vector_type(4)));
typedef unsigned v2u __attribute__((ext_vector_type(2)));
typedef float f32x4 __attribute__((ext_vector_type(4)));
typedef short bf16x8 __attribute__((ext_vector_type(8)));
typedef short s16x4 __attribute__((ext_vector_type(4)));
typedef GAS unsigned gu32;
#define RLX_AGENT __ATOMIC_RELAXED, __HIP_MEMORY_SCOPE_AGENT
#define LDS_WAIT() asm volatile("s_waitcnt lgkmcnt(0)" ::: "memory")
#define VM_WAIT() asm volatile("s_waitcnt vmcnt(0)" ::: "memory")
__device__ __forceinline__ unsigned pk2(float lo, float hi) { return pg8::cvt_pk_bf16(lo, hi); }
__device__ __forceinline__ float bflo(unsigned w) { return __builtin_bit_cast(float, w << 16); }
__device__ __forceinline__ float bfhi(unsigned w) { return __builtin_bit_cast(float, w & 0xffff0000u); }
__device__ __forceinline__ void unpack8(const v4u w, float (&f)[8]) { f[0] = bflo(w.x); f[1] = bfhi(w.x); f[2] = bflo(w.y); f[3] = bfhi(w.y); f[4] = bflo(w.z); f[5] = bfhi(w.z); f[6] = bflo(w.w); f[7] = bfhi(w.w); }
__device__ __forceinline__ v4u pack8(const float (&f)[8]) { v4u w; w.x = pk2(f[0], f[1]); w.y = pk2(f[2], f[3]); w.z = pk2(f[4], f[5]); w.w = pk2(f[6], f[7]); return w; }
__device__ __forceinline__ float wave_sum(float v) {
#pragma unroll
    for (int o = 1; o < 64; o <<= 1) v += __shfl_xor(v, o);
    return v;
}
__device__ __forceinline__ float silu_f(float x) { return x * __builtin_amdgcn_rcpf(1.0f + __builtin_amdgcn_exp2f(-1.4426950409f * x)); }

#define XB_TMO      128
#define XB_XCNT(j)  (256  + 64 * (j))
#define XB_XSUB(j)  (1280 + 64 * (j))
#define XB_XGEN(j)  (2304 + 64 * (j))
#define XB_TOP      3328
#define XB_TOPGEN   3392
#define XCD_BAR_WORDS 3456
#define XB_SPIN_CAP (1u << 18)

__device__ __forceinline__ unsigned xb_ld(unsigned* p)              { return __hip_atomic_load(p, __ATOMIC_RELAXED, __HIP_MEMORY_SCOPE_AGENT); }
__device__ __forceinline__ unsigned xb_add(unsigned* p, unsigned v) { return __hip_atomic_fetch_add(p, v, __ATOMIC_RELAXED, __HIP_MEMORY_SCOPE_AGENT); }
__device__ __forceinline__ unsigned xb_xcc_id() { return (unsigned)__builtin_amdgcn_s_getreg((3 << 11) | 20) & 0xFu; }
#define XB_SPIN(cond, bar) do { unsigned _sp = 0; while (cond) { __builtin_amdgcn_s_sleep(1); \
    if ((++_sp & 255u) == 0u) { if (xb_ld(&(bar)[XB_TMO])) break; if (_sp > XB_SPIN_CAP) { atomicAdd(&(bar)[XB_TMO], 1u); break; } } } } while (0)

struct XcdBarrier {
    unsigned* bar; unsigned x;
    volatile LAS unsigned* st;
};

__device__ __forceinline__ XcdBarrier xcd_barrier_post(unsigned* bar, volatile LAS unsigned* st) {
    XcdBarrier b; b.bar = bar; b.x = xb_xcc_id(); b.st = st;
    if (threadIdx.x == 0) (void)xb_add(&bar[XB_XCNT(b.x)], 1u);
    return b;
}
__device__ __forceinline__ void xcd_barrier_complete(unsigned* bar, unsigned x, unsigned& nloc, unsigned& nx) {
    const unsigned G = gridDim.x * gridDim.y * gridDim.z;
    unsigned sum, cnt, mine, sp = 0u;
    for (;;) {
        sum = 0u; cnt = 0u; mine = 0u;
#pragma unroll
        for (unsigned j = 0; j < 16; ++j) { const unsigned c = xb_ld(&bar[XB_XCNT(j)]); sum += c; cnt += (c > 0u) ? 1u : 0u; mine = (j == x) ? c : mine; }
        if (sum == G) break;
        __builtin_amdgcn_s_sleep(1);
        if ((++sp & 255u) == 0u) { if (xb_ld(&bar[XB_TMO])) break; if (sp > XB_SPIN_CAP) { atomicAdd(&bar[XB_TMO], 1u); break; } }
    }
    nloc = mine > 0u ? mine : 1u; nx = cnt > 0u ? cnt : 1u;
}

__device__ __forceinline__ void xcd_barrier(const XcdBarrier& b) {
    asm volatile("s_waitcnt vmcnt(0)" ::: "memory");
    __syncthreads();
    if (threadIdx.x == 0) {
        unsigned* bar = b.bar;
        __builtin_amdgcn_s_waitcnt(0);
        unsigned nloc = b.st[0], nx = b.st[1];
        if (nloc == 0u) { xcd_barrier_complete(bar, b.x, nloc, nx); b.st[0] = nloc; b.st[1] = nx; }
        const unsigned old = xb_add(&bar[XB_XSUB(b.x)], 1u);
        const unsigned gen = old / nloc;
        if (old + 1u == (gen + 1u) * nloc) {
            __builtin_amdgcn_fence(__ATOMIC_RELEASE, "agent");
            asm volatile("s_waitcnt vmcnt(0)" ::: "memory");
            const unsigned og = xb_add(&bar[XB_TOP], 1u);
            const unsigned tg = og / nx;
            if (og + 1u == (tg + 1u) * nx) xb_add(&bar[XB_TOPGEN], 1u);
            else XB_SPIN(xb_ld(&bar[XB_TOPGEN]) == tg, bar);
            __builtin_amdgcn_fence(__ATOMIC_ACQUIRE, "agent");
            xb_add(&bar[XB_XGEN(b.x)], 1u);
            asm volatile("s_waitcnt vmcnt(0)" ::: "memory");
        } else {
            XB_SPIN(xb_ld(&bar[XB_XGEN(b.x)]) == gen, bar);
            __builtin_amdgcn_fence(__ATOMIC_ACQUIRE, "agent");
            asm volatile("s_waitcnt vmcnt(0)" ::: "memory");
        }
    }
    __syncthreads();
}


struct Ctx {
    LAS unsigned char* lds;
    int tid, lane, wave, G, bid;
};
__device__ __forceinline__ unsigned long long karg_u64(int byte_off) {
    unsigned long long p; const unsigned long long ka = (unsigned long long)__builtin_amdgcn_kernarg_segment_ptr();
    asm volatile("s_load_dwordx2 %0, %1, %2\n\ts_waitcnt lgkmcnt(0)" : "=s"(p) : "s"(ka), "i"(byte_off) : "memory");
    return p;
}
__device__ __forceinline__ const float* karg(int k) { return (const float*)(const GAS float*)karg_u64(8 * k); }
__device__ __forceinline__ unsigned char* kws() { return (unsigned char*)(GAS unsigned char*)karg_u64(200); }
__device__ __forceinline__ float* kout() { return (float*)(GAS float*)karg_u64(192); }
__device__ __forceinline__ int opqv(int v) { asm volatile("" : "+v"(v)); return v; }
__device__ __forceinline__ int seq_of(int m) { return m < MP ? (m >> 11) : NP + ((m - MP) >> 3); }

__device__ __forceinline__ void p0_transpose_item(const float* W, int K, int N, bf16* WT, LAS float* T, int item, int lane) {
    const int nblk = N >> 6, kb = item / nblk, nb = item - kb * nblk;
    const float* src = W + (size_t)(64 * kb + (lane >> 4)) * N + 64 * nb + 4 * (lane & 15);
    f32x4 v[16];
#pragma unroll
    for (int i = 0; i < 16; ++i) v[i] = __builtin_nontemporal_load((const f32x4*)(src + (size_t)(4 * i) * N));
#pragma unroll
    for (int i = 0; i < 16; ++i) { const int k = 4 * i + (lane >> 4); *(LAS f32x4*)(T + k * 64 + ((4 * (lane & 15)) ^ (((k >> 3) & 7) << 2))) = v[i]; }
    LDS_WAIT(); asm volatile("" ::: "memory");
    const int c = lane & 7, nn = lane >> 3;
    bf16* dst = WT + (size_t)(64 * nb + nn) * K + 64 * kb + 8 * c;
#pragma unroll
    for (int ps = 0; ps < 8; ++ps) {
        const LAS float* t = T + (8 * c) * 64 + ((8 * ps + nn) ^ (c << 2));
        v4u o; o.x = pk2(t[0 * 64], t[1 * 64]); o.y = pk2(t[2 * 64], t[3 * 64]); o.z = pk2(t[4 * 64], t[5 * 64]); o.w = pk2(t[6 * 64], t[7 * 64]);
        *(v4u*)(dst + (size_t)(8 * ps) * K) = o;
    }
    LDS_WAIT(); asm volatile("" ::: "memory");
}
__device__ __forceinline__ void p0a_prologue(Ctx& F) {
    unsigned char* const ws = kws();
    const int lane = opqv(F.lane);
    const int gw = F.bid * NWAVES + F.wave, NGW = F.G * NWAVES;
    LAS float* T = (LAS float*)(F.lds + F.wave * 16384);
    constexpr int I_IN = (DM / 64) * (INC / 64), I_OUT = (DM / 64) * (DM / 64), I_UP = (DM / 64) * (FF2 / 64), I_DN = (FF / 64) * (DM / 64), I_ADA = (DM / 64) * (NMOD / 64);
    constexpr int I_LAYER = I_IN + I_OUT + I_UP + I_DN + I_ADA;
    for (int it = gw; it < NL * I_LAYER; it += NGW) {
        const int l = it / I_LAYER; int r = it - l * I_LAYER;
        const float* W; bf16* WT; int K, N;
        if (r < I_IN)                      { W = karg(12) + (size_t)l * DM * INC;  WT = ((bf16*)(ws + WS_WIN))  + (size_t)l * INC * DM;  K = DM; N = INC; }
        else if ((r -= I_IN) < I_OUT)      { W = karg(19) + (size_t)l * DM * DM;   WT = ((bf16*)(ws + WS_WOUT)) + (size_t)l * DM * DM;   K = DM; N = DM; }
        else if ((r -= I_OUT) < I_UP)      { W = karg(20) + (size_t)l * DM * FF2;  WT = ((bf16*)(ws + WS_WUP))  + (size_t)l * FF2 * DM;  K = DM; N = FF2; }
        else if ((r -= I_UP) < I_DN)       { W = karg(23) + (size_t)l * FF * DM;   WT = ((bf16*)(ws + WS_WDN))  + (size_t)l * DM * FF;   K = FF; N = DM; }
        else { r -= I_DN;                    W = karg(6)  + (size_t)l * DM * NMOD; WT = ((bf16*)(ws + WS_WADA)) + (size_t)l * NMOD * DM; K = DM; N = NMOD; }
        p0_transpose_item(W, K, N, WT, T, r, lane);
    }
    for (int r = gw; r < 256; r += NGW) {
        v2u* o = (v2u*)(((bf16*)(ws + WS_SC)) + (size_t)r * DM) + lane;
        if (r < NSEQ) { const f32x4* c = (const f32x4*)(r < NP ? karg(4) + (size_t)r * DM : karg(5) + (size_t)(r - NP) * DM) + lane;
#pragma unroll
            for (int j = 0; j < 8; ++j) { const f32x4 v = c[64 * j]; v2u w; w.x = pk2(silu_f(v.x), silu_f(v.y)); w.y = pk2(silu_f(v.z), silu_f(v.w)); o[64 * j] = w; } }
        else {
#pragma unroll
            for (int j = 0; j < 8; ++j) o[64 * j] = (v2u){0u, 0u}; }
    }
}
__device__ __forceinline__ const float* x_in_row(const Ctx& F, int m) { return m < MP ? karg(0) + (size_t)m * DM : karg(1) + (size_t)(m - MP) * DM; }
__device__ __forceinline__ void norm_mod_store(const f32x4 (&x)[8], const float* g, const float* sc, const float* sh, bf16* hrow, int lane) {
    float ss = 0.f;
#pragma unroll
    for (int j = 0; j < 8; ++j) ss += (x[j].x * x[j].x + x[j].y * x[j].y) + (x[j].z * x[j].z + x[j].w * x[j].w);
    const float rs = __builtin_amdgcn_rsqf(wave_sum(ss) * (1.0f / DM) + EPS);
    v2u* o = (v2u*)hrow + lane;
#pragma unroll
    for (int j = 0; j < 8; ++j) { const f32x4 gv = ((const f32x4*)g)[lane + 64 * j], sv = ((const f32x4*)sc)[lane + 64 * j], hv = ((const f32x4*)sh)[lane + 64 * j];
        const f32x4 h = x[j] * rs * gv * (sv + 1.0f) + hv; v2u w; w.x = pk2(h.x, h.y); w.y = pk2(h.z, h.w); o[64 * j] = w; }
}
__device__ __forceinline__ void p0c_h0(Ctx& F) {
    unsigned char* const ws = kws();
    const int lane = opqv(F.lane);
    const int gw = F.bid * NWAVES + F.wave, NGW = F.G * NWAVES;
    for (int m = gw; m < M; m += NGW) {
        const float* mod = ((float*)(ws + WS_MOD)) + (size_t)seq_of(m) * NMODALL;
        const f32x4* xr = (const f32x4*)x_in_row(F, m) + lane; f32x4 x[8];
#pragma unroll
        for (int j = 0; j < 8; ++j) x[j] = xr[64 * j];
        norm_mod_store(x, karg(8), mod + DM, mod, ((bf16*)(ws + WS_H)) + (size_t)m * DM, lane);
    }
}
template <bool MID> __device__ __forceinline__ void row_finish(f32x4 (&x)[8], const f32x4 (&y)[8], int m, int l, bool fin, const float* gpost, const float* gpre, unsigned char* ws, float* out, int lane) {
    const float* mod = ((float*)(ws + WS_MOD)) + (size_t)seq_of(m) * NMODALL + (size_t)l * NMOD;
    const float* gt = mod + (MID ? 2 : 5) * DM;
    const float* sc = MID ? mod + 4 * DM : mod + NMOD + DM;
    const float* sh = MID ? mod + 3 * DM : mod + NMOD;
    float ss = 0.f;
#pragma unroll
    for (int j = 0; j < 8; ++j) ss += (y[j].x * y[j].x + y[j].y * y[j].y) + (y[j].z * y[j].z + y[j].w * y[j].w);
    const float rs = __builtin_amdgcn_rsqf(wave_sum(ss) * (1.0f / DM) + EPS);
#pragma unroll
    for (int j = 0; j < 8; ++j) { const f32x4 gp = ((const f32x4*)gpost)[lane + 64 * j], gv = ((const f32x4*)gt)[lane + 64 * j]; x[j] = x[j] + gv * (y[j] * rs * gp); }
    if (fin) { f32x4* o = (f32x4*)(out + (size_t)m * DM) + lane;
#pragma unroll
        for (int j = 0; j < 8; ++j) o[64 * j] = x[j]; }
    else { f32x4* o = (f32x4*)(((float*)(ws + WS_X)) + (size_t)m * DM) + lane;
#pragma unroll
        for (int j = 0; j < 8; ++j) o[64 * j] = x[j];
        norm_mod_store(x, gpre, sc, sh, ((bf16*)(ws + WS_H)) + (size_t)m * DM, lane); }
}
template <bool MID> __device__ __forceinline__ void row_update(Ctx& F, int l) {
    unsigned char* const ws = kws();
    float* const out = kout();
    const int lane = opqv(F.lane);
    const int gw = F.bid * NWAVES + F.wave, NGW = F.G * NWAVES;
    const bool fin = !MID && (l == NL - 1);
    const float* gpost = (MID ? karg(9) : karg(11)) + (size_t)l * DM;
    const float* gpre = MID ? karg(10) + (size_t)l * DM : karg(8) + (size_t)(l + 1 < NL ? l + 1 : l) * DM;
    for (int ms = NGW - 1 - gw; ms < MS; ms += NGW) {
        const int m = MP + ms;
        const f32x4* xr = (const f32x4*)((MID && l == 0) ? x_in_row(F, m) : ((float*)(ws + WS_X)) + (size_t)m * DM) + lane;
        const f32x4* pr = (const f32x4*)(((float*)(ws + WS_PART)) + (size_t)ms * DM) + lane;
        f32x4 y[8], x[8];
#pragma unroll
        for (int j = 0; j < 8; ++j) { x[j] = xr[64 * j]; y[j] = pr[64 * j]; }
#pragma unroll
        for (int ks = 1; ks < 8; ++ks) {
#pragma unroll
            for (int j = 0; j < 8; ++j) y[j] = y[j] + pr[(size_t)ks * (MS * DM / 4) + 64 * j]; }
        row_finish<MID>(x, y, m, l, fin, gpost, gpre, ws, out, lane);
    }
    for (int m0 = gw; m0 < MP; m0 += 2 * NGW) {
        const int m1 = m0 + NGW; const bool two = m1 < MP;
        const int m1c = two ? m1 : m0;
        const f32x4* xr0 = (const f32x4*)((MID && l == 0) ? x_in_row(F, m0) : ((float*)(ws + WS_X)) + (size_t)m0 * DM) + lane;
        const f32x4* xr1 = (const f32x4*)((MID && l == 0) ? x_in_row(F, m1c) : ((float*)(ws + WS_X)) + (size_t)m1c * DM) + lane;
        const v2u* yr0 = (const v2u*)(((bf16*)(ws + WS_YB)) + (size_t)m0 * DM) + lane;
        const v2u* yr1 = (const v2u*)(((bf16*)(ws + WS_YB)) + (size_t)m1c * DM) + lane;
        f32x4 x0[8], x1[8], y0[8], y1[8]; v2u yb0[8], yb1[8];
#pragma unroll
        for (int j = 0; j < 8; ++j) { yb0[j] = yr0[64 * j]; yb1[j] = yr1[64 * j]; x0[j] = xr0[64 * j]; x1[j] = xr1[64 * j]; }
#pragma unroll
        for (int j = 0; j < 8; ++j) { y0[j] = (f32x4){bflo(yb0[j].x), bfhi(yb0[j].x), bflo(yb0[j].y), bfhi(yb0[j].y)}; y1[j] = (f32x4){bflo(yb1[j].x), bfhi(yb1[j].x), bflo(yb1[j].y), bfhi(yb1[j].y)}; }
        row_finish<MID>(x0, y0, m0, l, fin, gpost, gpre, ws, out, lane);
        if (two) row_finish<MID>(x1, y1, m1, l, fin, gpost, gpre, ws, out, lane);
    }
}
__device__ __forceinline__ s16x4 lds_tr16(LAS unsigned char* p) { return __builtin_bit_cast(s16x4, __builtin_amdgcn_ds_read_tr16_b64_v4i16((LAS s16x4*)p)); }
__device__ __forceinline__ void mixer_a_unit(Ctx& F, int l, int u) {
    unsigned char* const ws = kws();
    float* const out = kout();
    const int lane = opqv(F.lane), h = F.wave;
    const bool samp = u >= 64;
    const int bsel = u >> 4, ci = u & 15;
    const int m0 = samp ? MP + (u - 64) * 128 : bsel * TP + ci * 128;
    const bf16* P = ((bf16*)(ws + WS_PROJ)) + (size_t)m0 * INC;
    LAS float* R = (LAS float*)(F.lds + TAB_OFF);
    LAS float* SSQ = R + 128;
    __syncthreads();
    {
        const float* gv = karg(13) + (size_t)l * WA;
        const bool wr_rows = samp || ci == 15;
        for (int i = 0; i < 16; ++i) {
            const int s = 16 * h + i;
            const bf16* vr = P + (size_t)s * INC + WA;
            const v4u a = *(const v4u*)(vr + 8 * lane), b = *(const v4u*)(vr + 512 + 8 * lane);
            float fa[8], fb[8]; unpack8(a, fa); unpack8(b, fb);
            float ss = 0.f;
#pragma unroll
            for (int j = 0; j < 8; ++j) ss += fa[j] * fa[j] + fb[j] * fb[j];
            const float r = __builtin_amdgcn_rsqf(wave_sum(ss) * (1.0f / WA) + EPS);
            if (lane == 0) R[s] = r;
            if (wr_rows) {
                float* o = samp ? out + O_CVS + ((size_t)(((u - 64) * 16 + (s >> 3)) * NL + l) * TS + (s & 7)) * WA
                                : out + O_CVP + ((size_t)(bsel * NL + l) * 128 + s) * WA;
                const f32x4 g0 = *(const f32x4*)(gv + 8 * lane), g1 = *(const f32x4*)(gv + 8 * lane + 4), g2 = *(const f32x4*)(gv + 512 + 8 * lane), g3 = *(const f32x4*)(gv + 512 + 8 * lane + 4);
                *(f32x4*)(o + 8 * lane) = (f32x4){fa[0], fa[1], fa[2], fa[3]} * r * g0; *(f32x4*)(o + 8 * lane + 4) = (f32x4){fa[4], fa[5], fa[6], fa[7]} * r * g1;
                *(f32x4*)(o + 512 + 8 * lane) = (f32x4){fb[0], fb[1], fb[2], fb[3]} * r * g2; *(f32x4*)(o + 512 + 8 * lane + 4) = (f32x4){fb[4], fb[5], fb[6], fb[7]} * r * g3;
            }
        }
    }
    __syncthreads();
    LAS unsigned char* vt = F.lds + h * 16384;
    const float* Wsp = karg(14) + ((size_t)l * 8 + h) * 128 * 128;
    const float* bsp = karg(15) + (size_t)(l * 8 + h) * 128;
    const float* gvh = karg(13) + (size_t)l * WA + 128 * h;
    const float* gah = karg(17) + (size_t)l * WA + 128 * h;
    const int g = lane >> 4, i16 = lane & 15, q = i16 >> 2, p = i16 & 3;
#pragma unroll 1
    for (int dh = 0; dh < 2; ++dh) {
#pragma unroll
        for (int it = 0; it < 16; ++it) { const int s = it * 8 + (lane >> 3);
            const v4u x = *(const v4u*)(P + (size_t)s * INC + WA + 128 * h + 64 * dh + 8 * (lane & 7));
            *(LAS v4u*)(vt + s * 128 + (lane & 7) * 16) = x; }
        LDS_WAIT(); asm volatile("" ::: "memory");
        bf16x8 vf[4][4];
#pragma unroll
        for (int ks = 0; ks < 4; ++ks)
#pragma unroll
            for (int nt = 0; nt < 4; ++nt) { LAS unsigned char* a = vt + (32 * ks + 8 * g + q) * 128 + (16 * nt + 4 * p) * 2;
                const s16x4 lo = lds_tr16(a), hi = lds_tr16(a + 4 * 128);
                vf[ks][nt] = (bf16x8){lo[0], lo[1], lo[2], lo[3], hi[0], hi[1], hi[2], hi[3]}; }
#pragma unroll 1
        for (int tm = 0; tm < 8; ++tm) {
            const int t = 16 * tm + i16;
            const int tl = samp ? (t & 7) : t;
            const int nks = (tm >> 1) + 1;
            f32x4 acc[4];
#pragma unroll
            for (int nt = 0; nt < 4; ++nt) acc[nt] = (f32x4){0.f, 0.f, 0.f, 0.f};
#pragma unroll
            for (int ks = 0; ks < 4; ++ks) {
                if (ks < nks) {
                    const int s0 = 32 * ks + 8 * g;
                    const int sl0 = samp ? 0 : s0;
                    const bool blk = samp ? ((s0 >> 3) == (t >> 3)) : true;
                    const float* wp = Wsp + (size_t)tl * 128 + sl0;
                    const f32x4 w0 = *(const f32x4*)wp, w1 = *(const f32x4*)(wp + 4);
                    float w[8] = {w0.x, w0.y, w0.z, w0.w, w1.x, w1.y, w1.z, w1.w};
                    const f32x4 r0 = *(const LAS f32x4*)(R + s0), r1 = *(const LAS f32x4*)(R + s0 + 4);
                    const float rr[8] = {r0.x, r0.y, r0.z, r0.w, r1.x, r1.y, r1.z, r1.w};
#pragma unroll
                    for (int j = 0; j < 8; ++j) w[j] = (blk && (sl0 + j <= tl)) ? w[j] * rr[j] : 0.f;
                    v4u ww; ww.x = pk2(w[0], w[1]); ww.y = pk2(w[2], w[3]); ww.z = pk2(w[4], w[5]); ww.w = pk2(w[6], w[7]);
                    const bf16x8 wf = __builtin_bit_cast(bf16x8, ww);
#pragma unroll
                    for (int nt = 0; nt < 4; ++nt) acc[nt] = __builtin_amdgcn_mfma_f32_16x16x32_bf16(vf[ks][nt], wf, acc[nt], 0, 0, 0);
                }
            }
            const float bias = bsp[tl];
            const size_t m = (size_t)m0 + t;
            float ss = 0.f;
#pragma unroll
            for (int nt = 0; nt < 4; ++nt) {
                const int d = 64 * dh + 16 * nt + 4 * g;
                const v2u uw = *(const v2u*)(P + (size_t)t * INC + 128 * h + d);
                const f32x4 uu = (f32x4){bflo(uw.x), bfhi(uw.x), bflo(uw.y), bfhi(uw.y)};
                const f32x4 gv4 = *(const f32x4*)(gvh + d), ga4 = *(const f32x4*)(gah + d);
                const f32x4 o = uu * (acc[nt] * gv4 + bias);
                ss += (o.x * o.x + o.y * o.y) + (o.z * o.z + o.w * o.w);
                const f32x4 og = o * ga4; v2u w2; w2.x = pk2(og.x, og.y); w2.y = pk2(og.z, og.w);
                *(v2u*)(((bf16*)(ws + WS_MRG)) + m * DM + 128 * h + d) = w2;
            }
            ss += __shfl_xor(ss, 16); ss += __shfl_xor(ss, 32);
            if (g == 0) SSQ[(t * 8 + h) * 2 + dh] = ss;
        }
        LDS_WAIT(); asm volatile("" ::: "memory");
    }
    __syncthreads();
    for (int i = 0; i < 16; ++i) {
        const int s = 16 * h + i;
        const LAS f32x4* qq = (const LAS f32x4*)(SSQ + s * 16); const f32x4 q0 = qq[0], q1 = qq[1], q2 = qq[2], q3 = qq[3];
        const float tot = (((q0.x + q0.y) + (q0.z + q0.w)) + ((q1.x + q1.y) + (q1.z + q1.w))) + (((q2.x + q2.y) + (q2.z + q2.w)) + ((q3.x + q3.y) + (q3.z + q3.w)));
        const float ra = __builtin_amdgcn_rsqf(tot * (1.0f / WA) + EPS);
        bf16* row = ((bf16*)(ws + WS_MRG)) + ((size_t)m0 + s) * DM;
        float fa[8], fb[8]; unpack8(*(const v4u*)(row + 8 * lane), fa); unpack8(*(const v4u*)(row + 512 + 8 * lane), fb);
#pragma unroll
        for (int j = 0; j < 8; ++j) { fa[j] *= ra; fb[j] *= ra; }
        *(v4u*)(row + 8 * lane) = pack8(fa); *(v4u*)(row + 512 + 8 * lane) = pack8(fb);
    }
}
__device__ __forceinline__ void load16f(const float* p, int lane, float (&f)[16]) {
    const f32x4 a = *(const f32x4*)(p + 8 * lane), b = *(const f32x4*)(p + 8 * lane + 4), c = *(const f32x4*)(p + 512 + 8 * lane), d = *(const f32x4*)(p + 512 + 8 * lane + 4);
    f[0] = a.x; f[1] = a.y; f[2] = a.z; f[3] = a.w; f[4] = b.x; f[5] = b.y; f[6] = b.z; f[7] = b.w; f[8] = c.x; f[9] = c.y; f[10] = c.z; f[11] = c.w; f[12] = d.x; f[13] = d.y; f[14] = d.z; f[15] = d.w;
}
__device__ __forceinline__ void load16b(const bf16* p, int lane, float (&f)[16]) {
    float a[8], b[8]; unpack8(*(const v4u*)(p + 8 * lane), a); unpack8(*(const v4u*)(p + 512 + 8 * lane), b);
#pragma unroll
    for (int j = 0; j < 8; ++j) { f[j] = a[j]; f[8 + j] = b[j]; }
}
__device__ __forceinline__ void store16f(float* p, int lane, const float (&f)[16]) {
    *(f32x4*)(p + 8 * lane) = (f32x4){f[0], f[1], f[2], f[3]}; *(f32x4*)(p + 8 * lane + 4) = (f32x4){f[4], f[5], f[6], f[7]};
    *(f32x4*)(p + 512 + 8 * lane) = (f32x4){f[8], f[9], f[10], f[11]}; *(f32x4*)(p + 512 + 8 * lane + 4) = (f32x4){f[12], f[13], f[14], f[15]};
}
__device__ __forceinline__ void mixer_b_item(Ctx& F, int l, int seg) {
    unsigned char* const ws = kws();
    float* const out = kout();
    const int lane = opqv(F.lane);
    const int m0 = seg * 8;
    const bool samp = m0 >= MP;
    const int b = samp ? (m0 - MP) >> 3 : m0 >> 11, t0 = samp ? 0 : (m0 & (TP - 1));
    float w0[16], w1[16], w2[16], gb[16], p2[16], p1[16];
    load16f(karg(16) + (size_t)l * 3 * WB, lane, w0); load16f(karg(16) + (size_t)l * 3 * WB + WB, lane, w1); load16f(karg(16) + (size_t)l * 3 * WB + 2 * WB, lane, w2);
    load16f(karg(18) + (size_t)l * WB, lane, gb);
    if (samp) { const float* st = karg(2) + (size_t)(b * NL + l) * 2 * WB; load16f(st, lane, p2); load16f(st + WB, lane, p1); }
    else if (t0 == 0) {
#pragma unroll
        for (int j = 0; j < 16; ++j) { p2[j] = 0.f; p1[j] = 0.f; } }
    else { float a[16], c[16];
        load16b(((bf16*)(ws + WS_PROJ)) + (size_t)(m0 - 2) * INC + 3072, lane, a); load16b(((bf16*)(ws + WS_PROJ)) + (size_t)(m0 - 2) * INC + 4096, lane, c);
#pragma unroll
        for (int j = 0; j < 16; ++j) p2[j] = a[j] * c[j];
        load16b(((bf16*)(ws + WS_PROJ)) + (size_t)(m0 - 1) * INC + 3072, lane, a); load16b(((bf16*)(ws + WS_PROJ)) + (size_t)(m0 - 1) * INC + 4096, lane, c);
#pragma unroll
        for (int j = 0; j < 16; ++j) p1[j] = a[j] * c[j]; }
    const bool tail = samp || (t0 + 8 == TP);
    float* omix = (samp ? out + O_MIXS : out + O_MIXP) + (size_t)(b * NL + l) * 2 * WB;
#pragma unroll
    for (int r = 0; r < 8; ++r) {
        const bf16* pr = ((bf16*)(ws + WS_PROJ)) + (size_t)(m0 + r) * INC;
        float gbv[16], gc[16], hb[16], cin[16], ob[16];
        load16b(pr + 2048, lane, gbv); load16b(pr + 3072, lane, gc); load16b(pr + 4096, lane, hb);
        float ss = 0.f;
#pragma unroll
        for (int j = 0; j < 16; ++j) { cin[j] = gc[j] * hb[j]; ob[j] = gbv[j] * (w0[j] * p2[j] + w1[j] * p1[j] + w2[j] * cin[j]); ss += ob[j] * ob[j]; }
        const float rb = __builtin_amdgcn_rsqf(wave_sum(ss) * (1.0f / WB) + EPS);
        float oa[8], oc[8];
#pragma unroll
        for (int j = 0; j < 8; ++j) { oa[j] = ob[j] * rb * gb[j]; oc[j] = ob[8 + j] * rb * gb[8 + j]; }
        bf16* mr = ((bf16*)(ws + WS_MRG)) + (size_t)(m0 + r) * DM + WA;
        *(v4u*)(mr + 8 * lane) = pack8(oa); *(v4u*)(mr + 512 + 8 * lane) = pack8(oc);
        if (tail && r >= 6) store16f(omix + (size_t)(r - 6) * WB, lane, cin);
#pragma unroll
        for (int j = 0; j < 16; ++j) { p2[j] = p1[j]; p1[j] = cin[j]; }
    }
}
__device__ __forceinline__ void p2_mixer(Ctx& F, int l) {
    constexpr int NA = 72, NBB = (M / 8) / NWAVES;
    for (int u = F.bid; u < NA + NBB; u += F.G) {
        if (u < NA) { MA(mixer_a_unit(F, l, u)); }
        else { MB(mixer_b_item(F, l, (u - NA) * NWAVES + F.wave)); }
    }
}
__device__ __forceinline__ void conv_ffn_item(Ctx& F, int l, int item) {
    unsigned char* const ws = kws();
    float* const out = kout();
    const int lane = opqv(F.lane);
    const int seg = item / 11, cc = item - seg * 11;
    const bool samp = seg >= 512;
    const int b = samp ? seg - 512 : seg >> 7, t0 = samp ? 0 : (seg & 127) * 16, nrows = samp ? 8 : 16;
    const int m0 = samp ? MP + b * 8 : seg * 16;
    const int jg = cc * 512 + 8 * lane, jv = FF + jg;
    const float* wc = karg(21) + (size_t)l * 3 * FF2; const float* bc = karg(22) + (size_t)l * FF2;
    float w0g[8], w1g[8], w2g[8], bg[8], w0v[8], w1v[8], w2v[8], bv[8], g2[8], g1[8], v2[8], v1[8];
#define LD8F(dst, ptr) do { const f32x4 _a = *(const f32x4*)(ptr), _b = *(const f32x4*)((ptr) + 4); dst[0] = _a.x; dst[1] = _a.y; dst[2] = _a.z; dst[3] = _a.w; dst[4] = _b.x; dst[5] = _b.y; dst[6] = _b.z; dst[7] = _b.w; } while (0)
    LD8F(w0g, wc + jg); LD8F(w1g, wc + FF2 + jg); LD8F(w2g, wc + 2 * FF2 + jg); LD8F(bg, bc + jg);
    LD8F(w0v, wc + jv); LD8F(w1v, wc + FF2 + jv); LD8F(w2v, wc + 2 * FF2 + jv); LD8F(bv, bc + jv);
    if (samp) { const float* st = karg(3) + (size_t)(b * NL + l) * 2 * FF2; LD8F(g2, st + jg); LD8F(v2, st + jv); LD8F(g1, st + FF2 + jg); LD8F(v1, st + FF2 + jv); }
    else if (t0 == 0) {
#pragma unroll
        for (int j = 0; j < 8; ++j) { g2[j] = 0.f; g1[j] = 0.f; v2[j] = 0.f; v1[j] = 0.f; } }
    else { unpack8(*(const v4u*)(((bf16*)(ws + WS_UP)) + (size_t)(m0 - 2) * FF2 + jg), g2); unpack8(*(const v4u*)(((bf16*)(ws + WS_UP)) + (size_t)(m0 - 2) * FF2 + jv), v2);
           unpack8(*(const v4u*)(((bf16*)(ws + WS_UP)) + (size_t)(m0 - 1) * FF2 + jg), g1); unpack8(*(const v4u*)(((bf16*)(ws + WS_UP)) + (size_t)(m0 - 1) * FF2 + jv), v1); }
    const bool tail = samp || (t0 + 16 == TP);
    float* offn = (samp ? out + O_FFNS : out + O_FFNP) + (size_t)(b * NL + l) * 2 * FF2;
#pragma unroll 8
    for (int r = 0; r < nrows; ++r) {
        float xg[8], xv[8], a[8];
        unpack8(*(const v4u*)(((bf16*)(ws + WS_UP)) + (size_t)(m0 + r) * FF2 + jg), xg); unpack8(*(const v4u*)(((bf16*)(ws + WS_UP)) + (size_t)(m0 + r) * FF2 + jv), xv);
#pragma unroll
        for (int j = 0; j < 8; ++j) { const float G = w0g[j] * g2[j] + w1g[j] * g1[j] + w2g[j] * xg[j] + bg[j], V = w0v[j] * v2[j] + w1v[j] * v1[j] + w2v[j] * xv[j] + bv[j]; a[j] = silu_f(G) * V; }
        *(v4u*)(((bf16*)(ws + WS_ACT)) + (size_t)(m0 + r) * FF + jg) = pack8(a);
        if (tail && r >= nrows - 2) { float* o = offn + (size_t)(r - (nrows - 2)) * FF2;
            *(f32x4*)(o + jg) = (f32x4){xg[0], xg[1], xg[2], xg[3]}; *(f32x4*)(o + jg + 4) = (f32x4){xg[4], xg[5], xg[6], xg[7]};
            *(f32x4*)(o + jv) = (f32x4){xv[0], xv[1], xv[2], xv[3]}; *(f32x4*)(o + jv + 4) = (f32x4){xv[4], xv[5], xv[6], xv[7]}; }
#pragma unroll
        for (int j = 0; j < 8; ++j) { g2[j] = g1[j]; g1[j] = xg[j]; v2[j] = v1[j]; v1[j] = xv[j]; }
    }
#undef LD8F
}
__device__ __forceinline__ void p6_conv_ffn(Ctx& F, int l) {
    const int gw = F.bid * NWAVES + F.wave, NGW = F.G * NWAVES;
    constexpr int NITEMS = (512 + NS) * 11;
    for (int it = gw; it < NITEMS; it += NGW) conv_ffn_item(F, l, it);
}

__device__ __forceinline__ int opq(int v) { asm volatile("" : "+s"(v)); return v; }
struct Args { const float* in[24]; float* out; unsigned char* ws; int ph_lo, ph_hi; };
__global__ void __launch_bounds__(NTHREADS, 2) fwd(Args args) {
    extern __shared__ __attribute__((aligned(16))) unsigned char lds_raw[];
    Ctx F;
    F.lds = (LAS unsigned char*)lds_raw;
    volatile LAS unsigned* MISC = (volatile LAS unsigned*)(F.lds + MISC_OFF);
    F.tid = threadIdx.x; F.lane = F.tid & 63; F.wave = __builtin_amdgcn_readfirstlane(F.tid >> 6);
    F.G = gridDim.x; F.bid = blockIdx.x;
    gu32* ctl = (gu32*)(args.ws + WS_CTL);
    for (int u = F.tid; u < (LDS_BYTES - MISC_OFF) / 4; u += NTHREADS) ((LAS unsigned*)(F.lds + MISC_OFF))[u] = 0u;
    __syncthreads();
#if MK_PER_PHASE
#define SEAM(k) do { } while (0)
#else
    XcdBarrier bar = xcd_barrier_post((unsigned*)(ctl + CW_BAR), MISC + 8);
#define SEAM(k) do { if (lo <= (k) && (k) + 1 < hi) { for (int _r = 0; _r < REP_BAR; ++_r) xcd_barrier(bar); } } while (0)
#endif
    const int lo = args.ph_lo, hi = args.ph_hi;
#define IN(k) (lo <= (k) && (k) < hi)
    if (IN(0)) { T0(p0a_prologue(F)); }
    SEAM(0);
    if (IN(1)) {
        pg8::Gemm g{((bf16*)(kws() + WS_SC)), ((bf16*)(kws() + WS_WADA)), 256, NMODALL, DM}; pg8::StaticOrder S; S.init(256, NMODALL, DM, F.G, opq(F.bid));
        pg8::EpiF32 E{((float*)(kws() + WS_MOD)), NMODALL, karg(7), nullptr};
        GG0(pg8::gemm_phase<pg8::EpiF32, pg8::StaticOrder, true, true>(F.lds, g, S, E);)
    }
    SEAM(1);
    if (IN(2)) { T1(p0c_h0(F)); }
    SEAM(2);
#pragma unroll 1
    for (int l = 0; l < NL; ++l) {
        const int pb = 3 + 8 * l;
        if (IN(pb + 0)) {
            pg8::Gemm g{((bf16*)(kws() + WS_H)), ((bf16*)(kws() + WS_WIN)) + (size_t)l * INC * DM, M, INC, DM}; pg8::StaticOrder S; S.init(M, INC, DM, F.G, opq(F.bid));
            pg8::EpiBf16G E{((bf16*)(kws() + WS_PROJ)), INC, 8};
            GG1(pg8::gemm_phase<pg8::EpiBf16G, pg8::StaticOrder, true, true>(F.lds, g, S, E);)
        }
        SEAM(pb + 0);
        if (IN(pb + 1)) { T2(p2_mixer(F, l)); }
        SEAM(pb + 1);
        if (IN(pb + 2)) {
            pg8::Gemm g{((bf16*)(kws() + WS_MRG)), ((bf16*)(kws() + WS_WOUT)) + (size_t)l * DM * DM, M, DM, DM}; pg8::SplitOrder S; S.init(DM, F.G, opq(F.bid));
            pg8::EpiY E{((bf16*)(kws() + WS_YB)), ((float*)(kws() + WS_PART)), DM};
            GG2(pg8::gemm_phase<pg8::EpiY, pg8::SplitOrder, true, true>(F.lds, g, S, E);)
        }
        SEAM(pb + 2);
        if (IN(pb + 3)) { T3(row_update<true>(F, l)); }
        SEAM(pb + 3);
        if (IN(pb + 4)) {
            pg8::Gemm g{((bf16*)(kws() + WS_H)), ((bf16*)(kws() + WS_WUP)) + (size_t)l * FF2 * DM, M, FF2, DM}; pg8::StaticOrder S; S.init(M, FF2, DM, F.G, opq(F.bid));
            pg8::EpiBf16G E{((bf16*)(kws() + WS_UP)), FF2, 0};
            GG3(pg8::gemm_phase<pg8::EpiBf16G, pg8::StaticOrder, true, true>(F.lds, g, S, E);)
        }
        SEAM(pb + 4);
        if (IN(pb + 5)) { T4(p6_conv_ffn(F, l)); }
        SEAM(pb + 5);
        if (IN(pb + 6)) {
            pg8::Gemm g{((bf16*)(kws() + WS_ACT)), ((bf16*)(kws() + WS_WDN)) + (size_t)l * DM * FF, M, DM, FF}; pg8::SplitOrder S; S.init(FF, F.G, opq(F.bid));
            pg8::EpiY E{((bf16*)(kws() + WS_YB)), ((float*)(kws() + WS_PART)), DM};
            GG4(pg8::gemm_phase<pg8::EpiY, pg8::SplitOrder, true, true>(F.lds, g, S, E);)
        }
        SEAM(pb + 6);
        if (IN(pb + 7)) { T5(row_update<false>(F, l)); }
        SEAM(pb + 7);
    }
#undef IN
#undef SEAM
}

extern "C" void kernel_launch(void* const* d_in, const int* in_sizes, int n_in, void* d_out, int out_size, void* d_ws, size_t ws_size, hipStream_t stream) {
    static int grid = 0;
    if (grid == 0) {
        if (n_in != 24 || in_sizes[0] != MP * DM || (size_t)out_size != O_END || ws_size < WS_END) {
            fprintf(stderr, "kernel_launch: unexpected shapes (n_in %d, in0 %d, out %d, ws %zu); nothing launched\n", n_in, n_in > 0 ? in_sizes[0] : -1, out_size, ws_size); grid = -1; return; }
        int dev = 0, cus = 0, per_cu = 0;
        if (hipGetDevice(&dev) != hipSuccess || hipDeviceGetAttribute(&cus, hipDeviceAttributeMultiprocessorCount, dev) != hipSuccess) { grid = -1; return; }
        if (hipFuncSetAttribute((const void*)fwd, hipFuncAttributeMaxDynamicSharedMemorySize, LDS_BYTES) != hipSuccess) { fprintf(stderr, "kernel_launch: hipFuncSetAttribute failed\n"); grid = -1; return; }
        if (hipOccupancyMaxActiveBlocksPerMultiprocessor(&per_cu, (const void*)fwd, NTHREADS, LDS_BYTES) != hipSuccess || per_cu < 1) { fprintf(stderr, "kernel_launch: occupancy query says %d blocks per CU\n", per_cu); }
        (void)hipGetLastError();
        grid = cus;
    }
    if (grid < 0) return;
    if (hipMemsetAsync((char*)d_ws + WS_CTL, 0, CTL_ZERO_BYTES, stream) != hipSuccess) return;
    Args a{};
    for (int i = 0; i < 24; ++i) a.in[i] = (const float*)d_in[i];
    a.out = (float*)d_out; a.ws = (unsigned char*)d_ws;
#if MK_PER_PHASE
    for (int p = 0; p < NPHASES; ++p) { a.ph_lo = p; a.ph_hi = p + 1; hipLaunchKernelGGL(fwd, dim3(grid), dim3(NTHREADS), LDS_BYTES, stream, a); }
#else
    a.ph_lo = 0; a.ph_hi = NPHASES;
    hipLaunchKernelGGL(fwd, dim3(grid), dim3(NTHREADS), LDS_BYTES, stream, a);
#endif
    const hipError_t le = hipPeekAtLastError();
    if (le != hipSuccess) fprintf(stderr, "kernel_launch: launch failed: %s\n", hipGetErrorName(le));
}
```

```cpp
#include <hip/hip_runtime.h>
#include <cstdio>
#include <cstdint>
#ifndef MK_PER_PHASE
#define MK_PER_PHASE 0
#endif
#ifndef REP_GEMM
#define REP_GEMM 1
#endif
#ifndef REP_PRO
#define REP_PRO 1
#endif
#ifndef REP_MIX
#define REP_MIX 1
#endif
#ifndef REP_CONV
#define REP_CONV 1
#endif
#ifndef REP_ROW
#define REP_ROW 1
#endif
#ifndef REP_BAR
#define REP_BAR 1
#endif
#define GG0(...) for (int _r = 0; _r < REP_GEMM; ++_r) { __VA_ARGS__ }
#define GG1(...) for (int _r = 0; _r < REP_GEMM; ++_r) { __VA_ARGS__ }
#define GG2(...) for (int _r = 0; _r < REP_GEMM; ++_r) { __VA_ARGS__ }
#define GG3(...) for (int _r = 0; _r < REP_GEMM; ++_r) { __VA_ARGS__ }
#define GG4(...) for (int _r = 0; _r < REP_GEMM; ++_r) { __VA_ARGS__ }
#define T0(...) for (int _r = 0; _r < REP_PRO; ++_r) { __VA_ARGS__; }
#define T1(...) __VA_ARGS__
#define T2(...) for (int _r = 0; _r < REP_MIX; ++_r) { __VA_ARGS__; }
#define T3(...) __VA_ARGS__
#define T4(...) for (int _r = 0; _r < REP_CONV; ++_r) { __VA_ARGS__; }
#define T5(...) __VA_ARGS__
#define MA(...) __VA_ARGS__
#define MB(...) __VA_ARGS__
namespace pg8 {
#define PG8_LAS __attribute__((address_space(3)))
typedef unsigned short bf16_t;
typedef short bf16x8 __attribute__((ext_vector_type(8)));
typedef float f32x4 __attribute__((ext_vector_type(4)));
typedef unsigned u32x4 __attribute__((ext_vector_type(4)));
constexpr int BM = 256, BK = 64, HALF = 128, HTB = HALF * BK * 2  , STAGE_BYTES = 8 * HTB, NXCD = 8, WGM = 8;

__host__ __device__ __forceinline__ int lds_byte(int r, int c) { const int st = (r >> 4) * 2 + (c >> 5), rr = r & 15, cc = c & 31, ob = rr * 64 + cc * 2; return st * 1024 + (ob ^ (((ob >> 9) & 1) << 5)); }
__host__ __device__ __forceinline__ void stage_rc(int b, int& R, int& C) { const int st = b / 1024, sb = b % 1024, swz = sb ^ (((sb >> 9) & 1) << 5); R = (st >> 1) * 16 + swz / 64; C = (st & 1) * 32 + (swz % 64) / 2; }
__host__ __device__ __forceinline__ int perm32(int rho) { const int n = rho >> 4, i = rho & 15; return 8 * (i >> 2) + 4 * n + (i & 3); }

struct Unit { int pm, pn, ks; };
struct Gemm { const bf16_t* A; const bf16_t* Bt; int M, N, K; };

struct StaticOrder {
    int nM, nN, nwg, G, c, KT;
    __host__ __device__ void init(int M, int N, int K, int G_, int c_) { nM = M / BM; nN = N / BM; nwg = nM * nN; G = G_; c = c_; KT = K / BK; }
    __host__ __device__ bool next(int i, Unit& u) const {
        const long L = (long)i * G + c; if (L >= nwg) return false;
        int wgid = (int)L; { const int q = nwg / NXCD, r = nwg % NXCD, xcd = wgid % NXCD, off = wgid / NXCD; wgid = (xcd < r ? xcd * (q + 1) : r * (q + 1) + (xcd - r) * q) + off; }
        const int nig = WGM * nN, gid = wgid / nig, fm = gid * WGM, gsz = (nM - fm) < WGM ? (nM - fm) : WGM;
        u.pm = fm + ((wgid % nig) % gsz); u.pn = (wgid % nig) / gsz; u.ks = -1; return true;
    }
    __device__ __forceinline__ int k0(const Unit&) const { return 0; }
    __device__ __forceinline__ int nt(const Unit&) const { return KT; }
    __device__ __forceinline__ void a_ready(const Unit&) const {}
    __device__ __forceinline__ void done(const Unit&) const {}
};
struct SplitOrder {
    int G, c, KB;
    __host__ __device__ void init(int K, int G_, int c_) { G = G_; c = c_; KB = K / 128; }
    __host__ __device__ bool next(int i, Unit& u) const {
        const int L = i * G + c; if (L >= 512) return false;
        if (L < 256) { const int x = L & 7, j = L >> 3; u.pm = 4 * x + (j >> 3); u.pn = j & 7; u.ks = -1; }
        else { const int Ls = L - 256, j = Ls >> 3; u.pm = 32 + (j >> 3); u.pn = j & 7; u.ks = Ls & 7; }
        return true;
    }
    __device__ __forceinline__ int k0(const Unit& u) const { const int base = KB >> 3, rem = KB & 7; return u.ks < 0 ? 0 : 128 * (u.ks * base + (u.ks < rem ? u.ks : rem)); }
    __device__ __forceinline__ int nt(const Unit& u) const { const int base = KB >> 3, rem = KB & 7; return u.ks < 0 ? 2 * KB : 2 * (base + (u.ks < rem ? 1 : 0)); }
    __device__ __forceinline__ void a_ready(const Unit&) const {}
    __device__ __forceinline__ void done(const Unit&) const {}
};

__device__ __forceinline__ unsigned cvt_pk_bf16(float lo, float hi) { unsigned r; asm volatile("v_cvt_pk_bf16_f32 %0, %1, %2" : "=v"(r) : "v"(lo), "v"(hi)); return r; }
typedef float f32x2 __attribute__((ext_vector_type(2)));
__device__ __forceinline__ float gelu_tanh(float x) {
    const float z = x * (1.5957691216f + 0.0713548163f * x * x);
    const float e = __builtin_amdgcn_exp2f(-1.4426950409f * z);
    return x * __builtin_amdgcn_rcpf(1.0f + e);
}
struct EpiBf16G {
    static constexpr bool PERM = true, AFTER_DRAIN = false;
    bf16_t* O; int ldc; int ngelu;
    __device__ __forceinline__ void operator()(const f32x4 (&acc)[2][2][4][2], const Unit& u, int wr, int wc, int fr, int fq) const {
        const int row0 = u.pm * BM + wr * 64 + fr; const int col0 = u.pn * BM + wc * 32 + 8 * fq;
        const bool act = u.pn < ngelu;
#pragma unroll
        for (int ai = 0; ai < 2; ++ai)
#pragma unroll
            for (int m = 0; m < 4; ++m) { bf16_t* rowp = O + (size_t)(row0 + ai * HALF + m * 16) * ldc + col0;
#pragma unroll
                for (int bj = 0; bj < 2; ++bj) { f32x4 v0 = acc[ai][bj][m][0], v1 = acc[ai][bj][m][1];
                    if (act) {
#pragma unroll
                        for (int j = 0; j < 4; ++j) { v0[j] = gelu_tanh(v0[j]); v1[j] = gelu_tanh(v1[j]); } }
                    u32x4 w; w.x = cvt_pk_bf16(v0[0], v0[1]); w.y = cvt_pk_bf16(v0[2], v0[3]); w.z = cvt_pk_bf16(v1[0], v1[1]); w.w = cvt_pk_bf16(v1[2], v1[3]);
                    *(u32x4*)(rowp + bj * HALF) = w; } }
    }
};
struct EpiF32 {
    static constexpr bool PERM = false, AFTER_DRAIN = false;
    float* C; int ldc; const float* bias; float* Cpart;
    __device__ __forceinline__ void operator()(const f32x4 (&acc)[2][2][4][2], const Unit& u, int wr, int wc, int fr, int fq) const {
        const int row0 = u.pm * BM + wr * 64 + fr, col0 = u.pn * BM + wc * 32 + 4 * fq;
        float* Cb = u.ks < 0 ? C : Cpart + (ptrdiff_t)(u.ks * 1024 - 32 * BM) * ldc;
        f32x4 bv[2][2];
#pragma unroll
        for (int bj = 0; bj < 2; ++bj)
#pragma unroll
            for (int n = 0; n < 2; ++n) bv[bj][n] = bias ? *(const f32x4*)(bias + col0 + bj * HALF + n * 16) : (f32x4){0.f, 0.f, 0.f, 0.f};
#pragma unroll
        for (int ai = 0; ai < 2; ++ai)
#pragma unroll
            for (int m = 0; m < 4; ++m) { float* rowp = Cb + (size_t)(row0 + ai * HALF + m * 16) * ldc + col0;
#pragma unroll
                for (int bj = 0; bj < 2; ++bj)
#pragma unroll
                    for (int n = 0; n < 2; ++n) *(f32x4*)(rowp + bj * HALF + n * 16) = acc[ai][bj][m][n] + bv[bj][n]; }
    }
};
struct EpiY {
    static constexpr bool PERM = true, AFTER_DRAIN = false;
    bf16_t* Y; float* Cpart; int ldc;
    __device__ __forceinline__ void operator()(const f32x4 (&acc)[2][2][4][2], const Unit& u, int wr, int wc, int fr, int fq) const {
        const int row0 = u.pm * BM + wr * 64 + fr; const int col0 = u.pn * BM + wc * 32 + 8 * fq;
        if (u.ks < 0) {
#pragma unroll
            for (int ai = 0; ai < 2; ++ai)
#pragma unroll
                for (int m = 0; m < 4; ++m) { bf16_t* rowp = Y + (size_t)(row0 + ai * HALF + m * 16) * ldc + col0;
#pragma unroll
                    for (int bj = 0; bj < 2; ++bj) { const f32x4 v0 = acc[ai][bj][m][0], v1 = acc[ai][bj][m][1];
                        u32x4 w; w.x = cvt_pk_bf16(v0[0], v0[1]); w.y = cvt_pk_bf16(v0[2], v0[3]); w.z = cvt_pk_bf16(v1[0], v1[1]); w.w = cvt_pk_bf16(v1[2], v1[3]);
                        *(u32x4*)(rowp + bj * HALF) = w; } }
        } else {
            float* Cb = Cpart + (ptrdiff_t)(u.ks * 1024 - 32 * BM) * ldc;
#pragma unroll
            for (int ai = 0; ai < 2; ++ai)
#pragma unroll
                for (int m = 0; m < 4; ++m) { float* rowp = Cb + (size_t)(row0 + ai * HALF + m * 16) * ldc + col0;
#pragma unroll
                    for (int bj = 0; bj < 2; ++bj) { *(f32x4*)(rowp + bj * HALF) = acc[ai][bj][m][0]; *(f32x4*)(rowp + bj * HALF + 4) = acc[ai][bj][m][1]; } }
        }
    }
};
template <class Epi, class Sched, bool ALIGN_EPI = false, bool SP2 = false>
__device__ __forceinline__ void gemm_phase(PG8_LAS unsigned char* lds, const Gemm g, const Sched& S, const Epi& E) {
    int tid_ = threadIdx.x; asm volatile("" : "+v"(tid_));
    const int tid = tid_, wid = __builtin_amdgcn_readfirstlane(tid >> 6), lane = tid & 63, wr = wid >> 2, wc = wid & 3, fr = lane & 15, fq = lane >> 4;
    const int K = g.K;
    unsigned voffA[2], voffB[2];
#pragma unroll
    for (int i = 0; i < 2; ++i) { int R, C; stage_rc(tid * 16 + i * 8192, R, C); const int Rb = Epi::PERM ? ((R & ~31) + perm32(R & 31)) : R;
        voffA[i] = (unsigned)(R * K + C) * 2u; voffB[i] = (unsigned)(Rb * K + C) * 2u; }
    const size_t kstep = (size_t)(BK * 2);
    const size_t hstep = (size_t)HALF * K * 2;
    const size_t tstep = 2 * hstep;
    const unsigned ldsw = (unsigned)wid * 1024u;
    const int aoff = lds_byte(wr * 64 + fr, fq * 8), boff = lds_byte(wc * 32 + fr, fq * 8);
#define PG8_SA(b, h) (((b) * 2 + (h)) * HTB)
#define PG8_SB(b, h) ((4 + (b) * 2 + (h)) * HTB)
#define PG8_STAGE(bufoff, gbase, voff) do { _Pragma("unroll") for (int _i = 0; _i < 2; ++_i) \
        __builtin_amdgcn_global_load_lds((const unsigned*)((const char*)(gbase) + (voff)[_i]), (PG8_LAS unsigned*)(lds + (bufoff) + ldsw + _i * 8192), 16, 0, 0); } while (0)
#define PG8_LDA(dst, b, h) do { _Pragma("unroll") for (int m = 0; m < 4; ++m) _Pragma("unroll") for (int k = 0; k < 2; ++k) dst[m][k] = *(const PG8_LAS bf16x8*)(lds + PG8_SA(b, h) + aoff + m * 2048 + k * 1024); } while (0)
#define PG8_LDB(dst, b, h) do { _Pragma("unroll") for (int n = 0; n < 2; ++n) _Pragma("unroll") for (int k = 0; k < 2; ++k) dst[n][k] = *(const PG8_LAS bf16x8*)(lds + PG8_SB(b, h) + boff + n * 2048 + k * 1024); } while (0)
#define PG8_MMA(ai, bj, At, Bt) do { __builtin_amdgcn_s_setprio(1); _Pragma("unroll") for (int m = 0; m < 4; ++m) _Pragma("unroll") for (int n = 0; n < 2; ++n) _Pragma("unroll") for (int k = 0; k < 2; ++k) \
        acc[ai][bj][m][n] = __builtin_amdgcn_mfma_f32_16x16x32_bf16(Bt[n][k], At[m][k], acc[ai][bj][m][n], 0, 0, 0); __builtin_amdgcn_s_setprio(0); } while (0)
#define PG8_WAIT_V(n) asm volatile("s_waitcnt vmcnt(" #n ")" ::: "memory")
#define PG8_WAIT_L(n) asm volatile("s_waitcnt lgkmcnt(" #n ")" ::: "memory")
#define PG8_BAR __builtin_amdgcn_s_barrier()
#define PG8_SCHED __builtin_amdgcn_sched_barrier(0)
    Unit cur, nxt; int ui = 0;
    if (!S.next(0, cur)) return;
    f32x4 acc[2][2][4][2];
#pragma unroll
    for (int a = 0; a < 2; ++a)
#pragma unroll
        for (int b = 0; b < 2; ++b)
#pragma unroll
            for (int m = 0; m < 4; ++m)
#pragma unroll
                for (int n = 0; n < 2; ++n) acc[a][b][m][n] = (f32x4){0.f, 0.f, 0.f, 0.f};
    bf16x8 At[4][2], B0[2][2], B1[2][2];
    const char* cA = (const char*)g.A + (size_t)cur.pm * tstep + (size_t)S.k0(cur) * 2; const char* cB = (const char*)g.Bt + (size_t)cur.pn * tstep + (size_t)S.k0(cur) * 2;
    S.a_ready(cur);
    if constexpr (SP2) {
        PG8_STAGE(PG8_SB(0, 0), cB, voffB); PG8_STAGE(PG8_SB(0, 1), cB + hstep, voffB); PG8_STAGE(PG8_SA(0, 0), cA, voffA); PG8_STAGE(PG8_SA(0, 1), cA + hstep, voffA);
        if (wr == 1) PG8_BAR;
        PG8_WAIT_V(2); PG8_BAR;
        PG8_STAGE(PG8_SB(1, 0), cB + kstep, voffB); PG8_STAGE(PG8_SA(1, 0), cA + kstep, voffA); PG8_STAGE(PG8_SB(1, 1), cB + hstep + kstep, voffB);
        PG8_WAIT_V(6); PG8_BAR;
    } else {
        PG8_STAGE(PG8_SB(0, 0), cB, voffB); PG8_STAGE(PG8_SA(0, 0), cA, voffA); PG8_STAGE(PG8_SB(0, 1), cB + hstep, voffB); PG8_STAGE(PG8_SA(0, 1), cA + hstep, voffA);
        if (wr == 1) PG8_BAR;
        PG8_WAIT_V(4); PG8_BAR;
        PG8_STAGE(PG8_SB(1, 0), cB + kstep, voffB); PG8_STAGE(PG8_SA(1, 0), cA + kstep, voffA); PG8_STAGE(PG8_SB(1, 1), cB + hstep + kstep, voffB);
        PG8_WAIT_V(6); PG8_BAR;
    }
    for (;;) {
        const bool has_next = S.next(ui + 1, nxt);
        const char* nA = has_next ? (const char*)g.A + (size_t)nxt.pm * tstep + (size_t)S.k0(nxt) * 2 : cA; const char* nB = has_next ? (const char*)g.Bt + (size_t)nxt.pn * tstep + (size_t)S.k0(nxt) * 2 : cB;
        const int nt = S.nt(cur);
        for (int t = 0; t < nt; t += 2) {
            const bool last = (t == nt - 2);
            const char* a1 = cA + (size_t)(t + 1) * kstep;
            const char* a2 = last ? nA : cA + (size_t)(t + 2) * kstep; const char* b2 = last ? nB : cB + (size_t)(t + 2) * kstep;
            const char* a3 = a2 + kstep; const char* b3 = b2 + kstep;
            if (last && has_next) S.a_ready(nxt);
            if constexpr (SP2) {
            PG8_LDB(B0, 0, 0); PG8_LDB(B1, 0, 1); PG8_SCHED; PG8_LDA(At, 0, 0); PG8_STAGE(PG8_SA(1, 1), a1 + hstep, voffA);
            PG8_WAIT_V(8); PG8_WAIT_L(0); PG8_BAR; PG8_MMA(0, 0, At, B0); PG8_MMA(0, 1, At, B1); PG8_BAR; PG8_SCHED;
            PG8_LDA(At, 0, 1); PG8_STAGE(PG8_SB(0, 0), b2, voffB); PG8_STAGE(PG8_SB(0, 1), b2 + hstep, voffB); PG8_STAGE(PG8_SA(0, 0), a2, voffA);
            PG8_WAIT_V(8); PG8_WAIT_L(0); PG8_BAR; PG8_MMA(1, 0, At, B0); PG8_MMA(1, 1, At, B1); PG8_BAR; PG8_SCHED;
            PG8_LDB(B0, 1, 0); PG8_LDB(B1, 1, 1); PG8_SCHED; PG8_LDA(At, 1, 0); PG8_STAGE(PG8_SA(0, 1), a2 + hstep, voffA);
            PG8_WAIT_V(8); PG8_WAIT_L(0); PG8_BAR; PG8_MMA(0, 0, At, B0); PG8_MMA(0, 1, At, B1); PG8_BAR; PG8_SCHED;
            PG8_LDA(At, 1, 1); PG8_STAGE(PG8_SB(1, 0), b3, voffB); PG8_STAGE(PG8_SB(1, 1), b3 + hstep, voffB); PG8_STAGE(PG8_SA(1, 0), a3, voffA);
            PG8_WAIT_V(8); PG8_WAIT_L(0); PG8_BAR; PG8_MMA(1, 0, At, B0); PG8_MMA(1, 1, At, B1); PG8_BAR; PG8_SCHED;
            } else {
            PG8_LDB(B0, 0, 0); PG8_SCHED; PG8_LDA(At, 0, 0); PG8_STAGE(PG8_SA(1, 1), a1 + hstep, voffA);
            PG8_WAIT_L(8); PG8_BAR; PG8_WAIT_L(0); PG8_MMA(0, 0, At, B0); PG8_BAR; PG8_SCHED;
            PG8_LDB(B1, 0, 1); PG8_STAGE(PG8_SB(0, 0), b2, voffB);
            PG8_BAR; PG8_WAIT_L(0); PG8_MMA(0, 1, At, B1); PG8_BAR;
            PG8_LDA(At, 0, 1); PG8_STAGE(PG8_SA(0, 0), a2, voffA);
            PG8_BAR; PG8_WAIT_L(0); PG8_MMA(1, 0, At, B0); PG8_BAR; PG8_SCHED;
            PG8_STAGE(PG8_SB(0, 1), b2 + hstep, voffB);
            PG8_WAIT_V(6); PG8_BAR; PG8_MMA(1, 1, At, B1); PG8_BAR;
            PG8_LDB(B0, 1, 0); PG8_SCHED; PG8_LDA(At, 1, 0); PG8_STAGE(PG8_SA(0, 1), a2 + hstep, voffA);
            PG8_WAIT_L(8); PG8_BAR; PG8_WAIT_L(0); PG8_MMA(0, 0, At, B0); PG8_BAR; PG8_SCHED;
            PG8_LDB(B1, 1, 1); PG8_STAGE(PG8_SB(1, 0), b3, voffB);
            PG8_BAR; PG8_WAIT_L(0); PG8_MMA(0, 1, At, B1); PG8_BAR;
            PG8_LDA(At, 1, 1); PG8_STAGE(PG8_SA(1, 0), a3, voffA);
            PG8_BAR; PG8_WAIT_L(0); PG8_MMA(1, 0, At, B0); PG8_BAR; PG8_SCHED;
            PG8_STAGE(PG8_SB(1, 1), b3 + hstep, voffB);
            PG8_WAIT_V(6); PG8_BAR; PG8_MMA(1, 1, At, B1); PG8_BAR;
            }
        }
        if constexpr (ALIGN_EPI) { if (wr == 0) PG8_BAR; }
        if constexpr (!Epi::AFTER_DRAIN) { E(acc, cur, wr, wc, fr, fq); S.done(cur); }
        if (!has_next) break;
#pragma unroll
        for (int a = 0; a < 2; ++a)
#pragma unroll
            for (int b = 0; b < 2; ++b)
#pragma unroll
                for (int m = 0; m < 4; ++m)
#pragma unroll
                    for (int n = 0; n < 2; ++n) acc[a][b][m][n] = (f32x4){0.f, 0.f, 0.f, 0.f};
        cur = nxt; cA = nA; cB = nB; ++ui;
        if constexpr (ALIGN_EPI) { if (wr == 1) PG8_BAR; }
    }
    PG8_WAIT_V(0);
    if constexpr (!ALIGN_EPI) { if (wr == 0) PG8_BAR; }
    PG8_BAR;
    if constexpr (Epi::AFTER_DRAIN) { E.fused(acc, cur, wr, wc, fr, fq, lds, wid, lane); S.done(cur); }
#undef PG8_SA
#undef PG8_SB
#undef PG8_STAGE
#undef PG8_LDA
#undef PG8_LDB
#undef PG8_MMA
#undef PG8_WAIT_V
#undef PG8_WAIT_L
#undef PG8_BAR
#undef PG8_SCHED
}
}

constexpr int DM = 2048, NP = 4, TP = 2048, NL = 4, NS = 128, TS = 8;
constexpr int MP = NP * TP, MS = NS * TS, M = MP + MS;
constexpr int WA = 1024, WB = 1024, INC = 5120, FF = 5632, FF2 = 2 * FF, NMOD = 6 * DM, NMODALL = NL * NMOD;
constexpr int NSEQ = NP + NS;
constexpr float EPS = 1e-6f;
constexpr size_t O_YP = 0, O_YS = O_YP + (size_t)MP * DM, O_MIXP = O_YS + (size_t)MS * DM, O_MIXS = O_MIXP + (size_t)NP * NL * 2 * WB,
                 O_FFNP = O_MIXS + (size_t)NS * NL * 2 * WB, O_FFNS = O_FFNP + (size_t)NP * NL * 2 * FF2, O_CVP = O_FFNS + (size_t)NS * NL * 2 * FF2,
                 O_CVS = O_CVP + (size_t)NP * NL * 128 * WA, O_END = O_CVS + (size_t)NS * NL * TS * WA;
static_assert(O_END == 38141952, "output size");
constexpr size_t MiB = 1u << 20;
constexpr size_t WS_CTL = 0, CTL_ZERO_BYTES = 1 * MiB;
constexpr size_t WS_SC = 1 * MiB;
constexpr size_t WS_MOD = 2 * MiB;
constexpr size_t WS_WIN = 50 * MiB, WS_WOUT = 130 * MiB, WS_WUP = 162 * MiB, WS_WDN = 338 * MiB, WS_WADA = 426 * MiB;
constexpr size_t WS_X = 618 * MiB, WS_H = 690 * MiB, WS_PROJ = 726 * MiB, WS_MRG = 816 * MiB, WS_YB = 852 * MiB, WS_UP = 924 * MiB, WS_ACT = 1122 * MiB, WS_PART = 1221 * MiB, WS_END = 1285 * MiB;
static_assert(WS_MOD + (size_t)256 * NMODALL * 4 <= WS_WIN && WS_WIN + (size_t)NL * INC * DM * 2 <= WS_WOUT && WS_WOUT + (size_t)NL * DM * DM * 2 <= WS_WUP &&
              WS_WUP + (size_t)NL * FF2 * DM * 2 <= WS_WDN && WS_WDN + (size_t)NL * DM * FF * 2 <= WS_WADA && WS_WADA + (size_t)NMODALL * DM * 2 <= WS_X &&
              WS_X + (size_t)M * DM * 4 <= WS_H && WS_H + (size_t)M * DM * 2 <= WS_PROJ && WS_PROJ + (size_t)M * INC * 2 <= WS_MRG && WS_MRG + (size_t)M * DM * 2 <= WS_YB &&
              WS_YB + (size_t)M * DM * 2 <= WS_UP && WS_UP + (size_t)M * FF2 * 2 <= WS_ACT && WS_ACT + (size_t)M * FF * 2 <= WS_PART && WS_PART + (size_t)8 * MS * DM * 4 <= WS_END, "d_ws map");
constexpr int CW_BAR = 4096;
constexpr int RING_BYTES = 131072;
constexpr int MISC_OFF = RING_BYTES;
constexpr int TAB_OFF = RING_BYTES + 1024;
constexpr int LDS_BYTES = 147456;
constexpr int NWAVES = 8, NTHREADS = 512;
constexpr int NPHASES = 3 + 8 * NL;

#define GAS __attribute__((address_space(1)))
#define LAS __attribute__((address_space(3)))
typedef unsigned short bf16;
typedef unsigned v4u __attribute__((ext_vector_type(4)));
typedef unsigned v2u __attribute__((ext_vector_type(2)));
typedef float f32x4 __attribute__((ext_vector_type(4)));
typedef short bf16x8 __attribute__((ext_vector_type(8)));
typedef short s16x4 __attribute__((ext_vector_type(4)));
typedef GAS unsigned gu32;
#define RLX_AGENT __ATOMIC_RELAXED, __HIP_MEMORY_SCOPE_AGENT
#define LDS_WAIT() asm volatile("s_waitcnt lgkmcnt(0)" ::: "memory")
#define VM_WAIT() asm volatile("s_waitcnt vmcnt(0)" ::: "memory")
__device__ __forceinline__ unsigned pk2(float lo, float hi) { return pg8::cvt_pk_bf16(lo, hi); }
__device__ __forceinline__ float bflo(unsigned w) { return __builtin_bit_cast(float, w << 16); }
__device__ __forceinline__ float bfhi(unsigned w) { return __builtin_bit_cast(float, w & 0xffff0000u); }
__device__ __forceinline__ void unpack8(const v4u w, float (&f)[8]) { f[0] = bflo(w.x); f[1] = bfhi(w.x); f[2] = bflo(w.y); f[3] = bfhi(w.y); f[4] = bflo(w.z); f[5] = bfhi(w.z); f[6] = bflo(w.w); f[7] = bfhi(w.w); }
__device__ __forceinline__ v4u pack8(const float (&f)[8]) { v4u w; w.x = pk2(f[0], f[1]); w.y = pk2(f[2], f[3]); w.z = pk2(f[4], f[5]); w.w = pk2(f[6], f[7]); return w; }
__device__ __forceinline__ float wave_sum(float v) {
#pragma unroll
    for (int o = 1; o < 64; o <<= 1) v += __shfl_xor(v, o);
    return v;
}
__device__ __forceinline__ float silu_f(float x) { return x * __builtin_amdgcn_rcpf(1.0f + __builtin_amdgcn_exp2f(-1.4426950409f * x)); }

#define XB_TMO      128
#define XB_XCNT(j)  (256  + 64 * (j))
#define XB_XSUB(j)  (1280 + 64 * (j))
#define XB_XGEN(j)  (2304 + 64 * (j))
#define XB_TOP      3328
#define XB_TOPGEN   3392
#define XCD_BAR_WORDS 3456
#define XB_SPIN_CAP (1u << 18)

__device__ __forceinline__ unsigned xb_ld(unsigned* p)              { return __hip_atomic_load(p, __ATOMIC_RELAXED, __HIP_MEMORY_SCOPE_AGENT); }
__device__ __forceinline__ unsigned xb_add(unsigned* p, unsigned v) { return __hip_atomic_fetch_add(p, v, __ATOMIC_RELAXED, __HIP_MEMORY_SCOPE_AGENT); }
__device__ __forceinline__ unsigned xb_xcc_id() { return (unsigned)__builtin_amdgcn_s_getreg((3 << 11) | 20) & 0xFu; }
#define XB_SPIN(cond, bar) do { unsigned _sp = 0; while (cond) { __builtin_amdgcn_s_sleep(1); \
    if ((++_sp & 255u) == 0u) { if (xb_ld(&(bar)[XB_TMO])) break; if (_sp > XB_SPIN_CAP) { atomicAdd(&(bar)[XB_TMO], 1u); break; } } } } while (0)

struct XcdBarrier {
    unsigned* bar; unsigned x;
    volatile LAS unsigned* st;
};

__device__ __forceinline__ XcdBarrier xcd_barrier_post(unsigned* bar, volatile LAS unsigned* st) {
    XcdBarrier b; b.bar = bar; b.x = xb_xcc_id(); b.st = st;
    if (threadIdx.x == 0) (void)xb_add(&bar[XB_XCNT(b.x)], 1u);
    return b;
}
__device__ __forceinline__ void xcd_barrier_complete(unsigned* bar, unsigned x, unsigned& nloc, unsigned& nx) {
    const unsigned G = gridDim.x * gridDim.y * gridDim.z;
    unsigned sum, cnt, mine, sp = 0u;
    for (;;) {
        sum = 0u; cnt = 0u; mine = 0u;
#pragma unroll
        for (unsigned j = 0; j < 16; ++j) { const unsigned c = xb_ld(&bar[XB_XCNT(j)]); sum += c; cnt += (c > 0u) ? 1u : 0u; mine = (j == x) ? c : mine; }
        if (sum == G) break;
        __builtin_amdgcn_s_sleep(1);
        if ((++sp & 255u) == 0u) { if (xb_ld(&bar[XB_TMO])) break; if (sp > XB_SPIN_CAP) { atomicAdd(&bar[XB_TMO], 1u); break; } }
    }
    nloc = mine > 0u ? mine : 1u; nx = cnt > 0u ? cnt : 1u;
}

__device__ __forceinline__ void xcd_barrier(const XcdBarrier& b) {
    asm volatile("s_waitcnt vmcnt(0)" ::: "memory");
    __syncthreads();
    if (threadIdx.x == 0) {
        unsigned* bar = b.bar;
        __builtin_amdgcn_s_waitcnt(0);
        unsigned nloc = b.st[0], nx = b.st[1];
        if (nloc == 0u) { xcd_barrier_complete(bar, b.x, nloc, nx); b.st[0] = nloc; b.st[1] = nx; }
        const unsigned old = xb_add(&bar[XB_XSUB(b.x)], 1u);
        const unsigned gen = old / nloc;
        if (old + 1u == (gen + 1u) * nloc) {
            __builtin_amdgcn_fence(__ATOMIC_RELEASE, "agent");
            asm volatile("s_waitcnt vmcnt(0)" ::: "memory");
            const unsigned og = xb_add(&bar[XB_TOP], 1u);
            const unsigned tg = og / nx;
            if (og + 1u == (tg + 1u) * nx) xb_add(&bar[XB_TOPGEN], 1u);
            else XB_SPIN(xb_ld(&bar[XB_TOPGEN]) == tg, bar);
            __builtin_amdgcn_fence(__ATOMIC_ACQUIRE, "agent");
            xb_add(&bar[XB_XGEN(b.x)], 1u);
            asm volatile("s_waitcnt vmcnt(0)" ::: "memory");
        } else {
            XB_SPIN(xb_ld(&bar[XB_XGEN(b.x)]) == gen, bar);
            __builtin_amdgcn_fence(__ATOMIC_ACQUIRE, "agent");
            asm volatile("s_waitcnt vmcnt(0)" ::: "memory");
        }
    }
    __syncthreads();
}


struct Ctx {
    LAS unsigned char* lds;
    int tid, lane, wave, G, bid;
};
__device__ __forceinline__ unsigned long long karg_u64(int byte_off) {
    unsigned long long p; const unsigned long long ka = (unsigned long long)__builtin_amdgcn_kernarg_segment_ptr();
    asm volatile("s_load_dwordx2 %0, %1, %2\n\ts_waitcnt lgkmcnt(0)" : "=s"(p) : "s"(ka), "i"(byte_off) : "memory");
    return p;
}
__device__ __forceinline__ const float* karg(int k) { return (const float*)(const GAS float*)karg_u64(8 * k); }
__device__ __forceinline__ unsigned char* kws() { return (unsigned char*)(GAS unsigned char*)karg_u64(200); }
__device__ __forceinline__ float* kout() { return (float*)(GAS float*)karg_u64(192); }
__device__ __forceinline__ int opqv(int v) { asm volatile("" : "+v"(v)); return v; }
__device__ __forceinline__ int seq_of(int m) { return m < MP ? (m >> 11) : NP + ((m - MP) >> 3); }

__device__ __forceinline__ void p0_transpose_item(const float* W, int K, int N, bf16* WT, LAS float* T, int item, int lane) {
    const int nblk = N >> 6, kb = item / nblk, nb = item - kb * nblk;
    const float* src = W + (size_t)(64 * kb + (lane >> 4)) * N + 64 * nb + 4 * (lane & 15);
    f32x4 v[16];
#pragma unroll
    for (int i = 0; i < 16; ++i) v[i] = __builtin_nontemporal_load((const f32x4*)(src + (size_t)(4 * i) * N));
#pragma unroll
    for (int i = 0; i < 16; ++i) { const int k = 4 * i + (lane >> 4); *(LAS f32x4*)(T + k * 64 + ((4 * (lane & 15)) ^ (((k >> 3) & 7) << 2))) = v[i]; }
    LDS_WAIT(); asm volatile("" ::: "memory");
    const int c = lane & 7, nn = lane >> 3;
    bf16* dst = WT + (size_t)(64 * nb + nn) * K + 64 * kb + 8 * c;
#pragma unroll
    for (int ps = 0; ps < 8; ++ps) {
        const LAS float* t = T + (8 * c) * 64 + ((8 * ps + nn) ^ (c << 2));
        v4u o; o.x = pk2(t[0 * 64], t[1 * 64]); o.y = pk2(t[2 * 64], t[3 * 64]); o.z = pk2(t[4 * 64], t[5 * 64]); o.w = pk2(t[6 * 64], t[7 * 64]);
        *(v4u*)(dst + (size_t)(8 * ps) * K) = o;
    }
    LDS_WAIT(); asm volatile("" ::: "memory");
}
__device__ __forceinline__ void p0a_prologue(Ctx& F) {
    unsigned char* const ws = kws();
    const int lane = opqv(F.lane);
    const int gw = F.bid * NWAVES + F.wave, NGW = F.G * NWAVES;
    LAS float* T = (LAS float*)(F.lds + F.wave * 16384);
    constexpr int I_IN = (DM / 64) * (INC / 64), I_OUT = (DM / 64) * (DM / 64), I_UP = (DM / 64) * (FF2 / 64), I_DN = (FF / 64) * (DM / 64), I_ADA = (DM / 64) * (NMOD / 64);
    constexpr int I_LAYER = I_IN + I_OUT + I_UP + I_DN + I_ADA;
    for (int it = gw; it < NL * I_LAYER; it += NGW) {
        const int l = it / I_LAYER; int r = it - l * I_LAYER;
        const float* W; bf16* WT; int K, N;
        if (r < I_IN)                      { W = karg(12) + (size_t)l * DM * INC;  WT = ((bf16*)(ws + WS_WIN))  + (size_t)l * INC * DM;  K = DM; N = INC; }
        else if ((r -= I_IN) < I_OUT)      { W = karg(19) + (size_t)l * DM * DM;   WT = ((bf16*)(ws + WS_WOUT)) + (size_t)l * DM * DM;   K = DM; N = DM; }
        else if ((r -= I_OUT) < I_UP)      { W = karg(20) + (size_t)l * DM * FF2;  WT = ((bf16*)(ws + WS_WUP))  + (size_t)l * FF2 * DM;  K = DM; N = FF2; }
        else if ((r -= I_UP) < I_DN)       { W = karg(23) + (size_t)l * FF * DM;   WT = ((bf16*)(ws + WS_WDN))  + (size_t)l * DM * FF;   K = FF; N = DM; }
        else { r -= I_DN;                    W = karg(6)  + (size_t)l * DM * NMOD; WT = ((bf16*)(ws + WS_WADA)) + (size_t)l * NMOD * DM; K = DM; N = NMOD; }
        p0_transpose_item(W, K, N, WT, T, r, lane);
    }
    for (int r = gw; r < 256; r += NGW) {
        v2u* o = (v2u*)(((bf16*)(ws + WS_SC)) + (size_t)r * DM) + lane;
        if (r < NSEQ) { const f32x4* c = (const f32x4*)(r < NP ? karg(4) + (size_t)r * DM : karg(5) + (size_t)(r - NP) * DM) + lane;
#pragma unroll
            for (int j = 0; j < 8; ++j) { const f32x4 v = c[64 * j]; v2u w; w.x = pk2(silu_f(v.x), silu_f(v.y)); w.y = pk2(silu_f(v.z), silu_f(v.w)); o[64 * j] = w; } }
        else {
#pragma unroll
            for (int j = 0; j < 8; ++j) o[64 * j] = (v2u){0u, 0u}; }
    }
}
__device__ __forceinline__ const float* x_in_row(const Ctx& F, int m) { return m < MP ? karg(0) + (size_t)m * DM : karg(1) + (size_t)(m - MP) * DM; }
__device__ __forceinline__ void norm_mod_store(const f32x4 (&x)[8], const float* g, const float* sc, const float* sh, bf16* hrow, int lane) {
    float ss = 0.f;
#pragma unroll
    for (int j = 0; j < 8; ++j) ss += (x[j].x * x[j].x + x[j].y * x[j].y) + (x[j].z * x[j].z + x[j].w * x[j].w);
    const float rs = __builtin_amdgcn_rsqf(wave_sum(ss) * (1.0f / DM) + EPS);
    v2u* o = (v2u*)hrow + lane;
#pragma unroll
    for (int j = 0; j < 8; ++j) { const f32x4 gv = ((const f32x4*)g)[lane + 64 * j], sv = ((const f32x4*)sc)[lane + 64 * j], hv = ((const f32x4*)sh)[lane + 64 * j];
        const f32x4 h = x[j] * rs * gv * (sv + 1.0f) + hv; v2u w; w.x = pk2(h.x, h.y); w.y = pk2(h.z, h.w); o[64 * j] = w; }
}
__device__ __forceinline__ void p0c_h0(Ctx& F) {
    unsigned char* const ws = kws();
    const int lane = opqv(F.lane);
    const int gw = F.bid * NWAVES + F.wave, NGW = F.G * NWAVES;
    for (int m = gw; m < M; m += NGW) {
        const float* mod = ((float*)(ws + WS_MOD)) + (size_t)seq_of(m) * NMODALL;
        const f32x4* xr = (const f32x4*)x_in_row(F, m) + lane; f32x4 x[8];
#pragma unroll
        for (int j = 0; j < 8; ++j) x[j] = xr[64 * j];
        norm_mod_store(x, karg(8), mod + DM, mod, ((bf16*)(ws + WS_H)) + (size_t)m * DM, lane);
    }
}
template <bool MID> __device__ __forceinline__ void row_finish(f32x4 (&x)[8], const f32x4 (&y)[8], int m, int l, bool fin, const float* gpost, const float* gpre, unsigned char* ws, float* out, int lane) {
    const float* mod = ((float*)(ws + WS_MOD)) + (size_t)seq_of(m) * NMODALL + (size_t)l * NMOD;
    const float* gt = mod + (MID ? 2 : 5) * DM;
    const float* sc = MID ? mod + 4 * DM : mod + NMOD + DM;
    const float* sh = MID ? mod + 3 * DM : mod + NMOD;
    float ss = 0.f;
#pragma unroll
    for (int j = 0; j < 8; ++j) ss += (y[j].x * y[j].x + y[j].y * y[j].y) + (y[j].z * y[j].z + y[j].w * y[j].w);
    const float rs = __builtin_amdgcn_rsqf(wave_sum(ss) * (1.0f / DM) + EPS);
#pragma unroll
    for (int j = 0; j < 8; ++j) { const f32x4 gp = ((const f32x4*)gpost)[lane + 64 * j], gv = ((const f32x4*)gt)[lane + 64 * j]; x[j] = x[j] + gv * (y[j] * rs * gp); }
    if (fin) { f32x4* o = (f32x4*)(out + (size_t)m * DM) + lane;
#pragma unroll
        for (int j = 0; j < 8; ++j) o[64 * j] = x[j]; }
    else { f32x4* o = (f32x4*)(((float*)(ws + WS_X)) + (size_t)m * DM) + lane;
#pragma unroll
        for (int j = 0; j < 8; ++j) o[64 * j] = x[j];
        norm_mod_store(x, gpre, sc, sh, ((bf16*)(ws + WS_H)) + (size_t)m * DM, lane); }
}
template <bool MID> __device__ __forceinline__ void row_update(Ctx& F, int l) {
    unsigned char* const ws = kws();
    float* const out = kout();
    const int lane = opqv(F.lane);
    const int gw = F.bid * NWAVES + F.wave, NGW = F.G * NWAVES;
    const bool fin = !MID && (l == NL - 1);
    const float* gpost = (MID ? karg(9) : karg(11)) + (size_t)l * DM;
    const float* gpre = MID ? karg(10) + (size_t)l * DM : karg(8) + (size_t)(l + 1 < NL ? l + 1 : l) * DM;
    for (int ms = NGW - 1 - gw; ms < MS; ms += NGW) {
        const int m = MP + ms;
        const f32x4* xr = (const f32x4*)((MID && l == 0) ? x_in_row(F, m) : ((float*)(ws + WS_X)) + (size_t)m * DM) + lane;
        const f32x4* pr = (const f32x4*)(((float*)(ws + WS_PART)) + (size_t)ms * DM) + lane;
        f32x4 y[8], x[8];
#pragma unroll
        for (int j = 0; j < 8; ++j) { x[j] = xr[64 * j]; y[j] = pr[64 * j]; }
#pragma unroll
        for (int ks = 1; ks < 8; ++ks) {
#pragma unroll
            for (int j = 0; j < 8; ++j) y[j] = y[j] + pr[(size_t)ks * (MS * DM / 4) + 64 * j]; }
        row_finish<MID>(x, y, m, l, fin, gpost, gpre, ws, out, lane);
    }
    for (int m0 = gw; m0 < MP; m0 += 2 * NGW) {
        const int m1 = m0 + NGW; const bool two = m1 < MP;
        const int m1c = two ? m1 : m0;
        const f32x4* xr0 = (const f32x4*)((MID && l == 0) ? x_in_row(F, m0) : ((float*)(ws + WS_X)) + (size_t)m0 * DM) + lane;
        const f32x4* xr1 = (const f32x4*)((MID && l == 0) ? x_in_row(F, m1c) : ((float*)(ws + WS_X)) + (size_t)m1c * DM) + lane;
        const v2u* yr0 = (const v2u*)(((bf16*)(ws + WS_YB)) + (size_t)m0 * DM) + lane;
        const v2u* yr1 = (const v2u*)(((bf16*)(ws + WS_YB)) + (size_t)m1c * DM) + lane;
        f32x4 x0[8], x1[8], y0[8], y1[8]; v2u yb0[8], yb1[8];
#pragma unroll
        for (int j = 0; j < 8; ++j) { yb0[j] = yr0[64 * j]; yb1[j] = yr1[64 * j]; x0[j] = xr0[64 * j]; x1[j] = xr1[64 * j]; }
#pragma unroll
        for (int j = 0; j < 8; ++j) { y0[j] = (f32x4){bflo(yb0[j].x), bfhi(yb0[j].x), bflo(yb0[j].y), bfhi(yb0[j].y)}; y1[j] = (f32x4){bflo(yb1[j].x), bfhi(yb1[j].x), bflo(yb1[j].y), bfhi(yb1[j].y)}; }
        row_finish<MID>(x0, y0, m0, l, fin, gpost, gpre, ws, out, lane);
        if (two) row_finish<MID>(x1, y1, m1, l, fin, gpost, gpre, ws, out, lane);
    }
}
__device__ __forceinline__ s16x4 lds_tr16(LAS unsigned char* p) { return __builtin_bit_cast(s16x4, __builtin_amdgcn_ds_read_tr16_b64_v4i16((LAS s16x4*)p)); }
__device__ __forceinline__ void mixer_a_unit(Ctx& F, int l, int ua) {
    unsigned char* const ws = kws();
    float* const out = kout();
    const int lane = opqv(F.lane), h = F.wave;
    const int u = ua >> 1, th = ua & 1;
    const bool samp = u >= 64;
    const int bsel = u >> 4, ci = u & 15;
    const int m0 = samp ? MP + (u - 64) * 128 : bsel * TP + ci * 128;
    const bf16* P = ((bf16*)(ws + WS_PROJ)) + (size_t)m0 * INC;
    LAS float* R = (LAS float*)(F.lds + TAB_OFF);
    LAS float* SSQ = R + 128;
    __syncthreads();
    {
        const float* gv = karg(13) + (size_t)l * WA;
        const bool wr_rows = samp || ci == 15;
#pragma unroll 1
        for (int bt = 0; bt <= th; ++bt) {
            v4u va[8], vb[8];
#pragma unroll
            for (int i = 0; i < 8; ++i) { const bf16* vr = P + (size_t)(64 * bt + 8 * h + i) * INC + WA; va[i] = *(const v4u*)(vr + 8 * lane); vb[i] = *(const v4u*)(vr + 512 + 8 * lane); }
#pragma unroll
            for (int i = 0; i < 8; ++i) {
                const int s = 64 * bt + 8 * h + i;
                float fa[8], fb[8]; unpack8(va[i], fa); unpack8(vb[i], fb);
                float ss = 0.f;
#pragma unroll
                for (int j = 0; j < 8; ++j) ss += fa[j] * fa[j] + fb[j] * fb[j];
                const float r = __builtin_amdgcn_rsqf(wave_sum(ss) * (1.0f / WA) + EPS);
                if (lane == 0) R[s] = r;
                if (wr_rows && bt == th) {
                    float* o = samp ? out + O_CVS + ((size_t)(((u - 64) * 16 + (s >> 3)) * NL + l) * TS + (s & 7)) * WA
                                    : out + O_CVP + ((size_t)(bsel * NL + l) * 128 + s) * WA;
                    const f32x4 g0 = *(const f32x4*)(gv + 8 * lane), g1 = *(const f32x4*)(gv + 8 * lane + 4), g2 = *(const f32x4*)(gv + 512 + 8 * lane), g3 = *(const f32x4*)(gv + 512 + 8 * lane + 4);
                    *(f32x4*)(o + 8 * lane) = (f32x4){fa[0], fa[1], fa[2], fa[3]} * r * g0; *(f32x4*)(o + 8 * lane + 4) = (f32x4){fa[4], fa[5], fa[6], fa[7]} * r * g1;
                    *(f32x4*)(o + 512 + 8 * lane) = (f32x4){fb[0], fb[1], fb[2], fb[3]} * r * g2; *(f32x4*)(o + 512 + 8 * lane + 4) = (f32x4){fb[4], fb[5], fb[6], fb[7]} * r * g3;
                }
            }
        }
    }
    __syncthreads();
    LAS unsigned char* vt = F.lds + h * 16384;
    const float* Wsp = karg(14) + ((size_t)l * 8 + h) * 128 * 128;
    const float* bsp = karg(15) + (size_t)(l * 8 + h) * 128;
    const float* gvh = karg(13) + (size_t)l * WA + 128 * h;
    const float* gah = karg(17) + (size_t)l * WA + 128 * h;
    const int g = lane >> 4, i16 = lane & 15, q = i16 >> 2, p = i16 & 3;
#pragma unroll 1
    for (int dh = 0; dh < 2; ++dh) {
        {
            v4u x[16];
#pragma unroll
            for (int it = 0; it < 16; ++it) { const int s = it * 8 + (lane >> 3); if (it < 8 * (th + 1)) x[it] = *(const v4u*)(P + (size_t)s * INC + WA + 128 * h + 64 * dh + 8 * (lane & 7)); }
#pragma unroll
            for (int it = 0; it < 16; ++it) { const int s = it * 8 + (lane >> 3); if (it < 8 * (th + 1)) *(LAS v4u*)(vt + s * 128 + (lane & 7) * 16) = x[it]; }
        }
        LDS_WAIT(); asm volatile("" ::: "memory");
        bf16x8 vf[4][4];
#pragma unroll
        for (int ks = 0; ks < 4; ++ks)
#pragma unroll
            for (int nt = 0; nt < 4; ++nt) { LAS unsigned char* a = vt + (32 * ks + 8 * g + q) * 128 + (16 * nt + 4 * p) * 2;
                const s16x4 lo = lds_tr16(a), hi = lds_tr16(a + 4 * 128);
                vf[ks][nt] = (bf16x8){lo[0], lo[1], lo[2], lo[3], hi[0], hi[1], hi[2], hi[3]}; }
#pragma unroll 2
        for (int tm = 4 * th; tm < 4 * th + 4; ++tm) {
            const int t = 16 * tm + i16;
            const int tl = samp ? (t & 7) : t;
            const int nks = (tm >> 1) + 1;
            f32x4 acc[4];
#pragma unroll
            for (int nt = 0; nt < 4; ++nt) acc[nt] = (f32x4){0.f, 0.f, 0.f, 0.f};
#pragma unroll
            for (int ks = 0; ks < 4; ++ks) {
                if (ks < nks) {
                    const int s0 = 32 * ks + 8 * g;
                    const int sl0 = samp ? 0 : s0;
                    const bool blk = samp ? ((s0 >> 3) == (t >> 3)) : true;
                    const float* wp = Wsp + (size_t)tl * 128 + sl0;
                    const f32x4 w0 = *(const f32x4*)wp, w1 = *(const f32x4*)(wp + 4);
                    float w[8] = {w0.x, w0.y, w0.z, w0.w, w1.x, w1.y, w1.z, w1.w};
                    const f32x4 r0 = *(const LAS f32x4*)(R + s0), r1 = *(const LAS f32x4*)(R + s0 + 4);
                    const float rr[8] = {r0.x, r0.y, r0.z, r0.w, r1.x, r1.y, r1.z, r1.w};
#pragma unroll
                    for (int j = 0; j < 8; ++j) w[j] = (blk && (sl0 + j <= tl)) ? w[j] * rr[j] : 0.f;
                    v4u ww; ww.x = pk2(w[0], w[1]); ww.y = pk2(w[2], w[3]); ww.z = pk2(w[4], w[5]); ww.w = pk2(w[6], w[7]);
                    const bf16x8 wf = __builtin_bit_cast(bf16x8, ww);
#pragma unroll
                    for (int nt = 0; nt < 4; ++nt) acc[nt] = __builtin_amdgcn_mfma_f32_16x16x32_bf16(vf[ks][nt], wf, acc[nt], 0, 0, 0);
                }
            }
            const float bias = bsp[tl];
            const size_t m = (size_t)m0 + t;
            float ss = 0.f;
#pragma unroll
            for (int nt = 0; nt < 4; ++nt) {
                const int d = 64 * dh + 16 * nt + 4 * g;
                const v2u uw = *(const v2u*)(P + (size_t)t * INC + 128 * h + d);
                const f32x4 uu = (f32x4){bflo(uw.x), bfhi(uw.x), bflo(uw.y), bfhi(uw.y)};
                const f32x4 gv4 = *(const f32x4*)(gvh + d), ga4 = *(const f32x4*)(gah + d);
                const f32x4 o = uu * (acc[nt] * gv4 + bias);
                ss += (o.x * o.x + o.y * o.y) + (o.z * o.z + o.w * o.w);
                const f32x4 og = o * ga4; v2u w2; w2.x = pk2(og.x, og.y); w2.y = pk2(og.z, og.w);
                *(v2u*)(((bf16*)(ws + WS_MRG)) + m * DM + 128 * h + d) = w2;
            }
            ss += __shfl_xor(ss, 16); ss += __shfl_xor(ss, 32);
            if (g == 0) SSQ[(t * 8 + h) * 2 + dh] = ss;
        }
        LDS_WAIT(); asm volatile("" ::: "memory");
    }
    __syncthreads();
    {
        v4u ra_[8], rb_[8];
#pragma unroll
        for (int i = 0; i < 8; ++i) { const bf16* row = ((bf16*)(ws + WS_MRG)) + ((size_t)m0 + 64 * th + 8 * h + i) * DM; ra_[i] = *(const v4u*)(row + 8 * lane); rb_[i] = *(const v4u*)(row + 512 + 8 * lane); }
#pragma unroll
        for (int i = 0; i < 8; ++i) {
            const int s = 64 * th + 8 * h + i;
            const LAS f32x4* qq = (const LAS f32x4*)(SSQ + s * 16); const f32x4 q0 = qq[0], q1 = qq[1], q2 = qq[2], q3 = qq[3];
            const float tot = (((q0.x + q0.y) + (q0.z + q0.w)) + ((q1.x + q1.y) + (q1.z + q1.w))) + (((q2.x + q2.y) + (q2.z + q2.w)) + ((q3.x + q3.y) + (q3.z + q3.w)));
            const float ra = __builtin_amdgcn_rsqf(tot * (1.0f / WA) + EPS);
            bf16* row = ((bf16*)(ws + WS_MRG)) + ((size_t)m0 + s) * DM;
            float fa[8], fb[8]; unpack8(ra_[i], fa); unpack8(rb_[i], fb);
#pragma unroll
            for (int j = 0; j < 8; ++j) { fa[j] *= ra; fb[j] *= ra; }
            *(v4u*)(row + 8 * lane) = pack8(fa); *(v4u*)(row + 512 + 8 * lane) = pack8(fb);
        }
    }
}
__device__ __forceinline__ void load16f(const float* p, int lane, float (&f)[16]) {
    const f32x4 a = *(const f32x4*)(p + 8 * lane), b = *(const f32x4*)(p + 8 * lane + 4), c = *(const f32x4*)(p + 512 + 8 * lane), d = *(const f32x4*)(p + 512 + 8 * lane + 4);
    f[0] = a.x; f[1] = a.y; f[2] = a.z; f[3] = a.w; f[4] = b.x; f[5] = b.y; f[6] = b.z; f[7] = b.w; f[8] = c.x; f[9] = c.y; f[10] = c.z; f[11] = c.w; f[12] = d.x; f[13] = d.y; f[14] = d.z; f[15] = d.w;
}
__device__ __forceinline__ void load16b(const bf16* p, int lane, float (&f)[16]) {
    float a[8], b[8]; unpack8(*(const v4u*)(p + 8 * lane), a); unpack8(*(const v4u*)(p + 512 + 8 * lane), b);
#pragma unroll
    for (int j = 0; j < 8; ++j) { f[j] = a[j]; f[8 + j] = b[j]; }
}
__device__ __forceinline__ void store16f(float* p, int lane, const float (&f)[16]) {
    *(f32x4*)(p + 8 * lane) = (f32x4){f[0], f[1], f[2], f[3]}; *(f32x4*)(p + 8 * lane + 4) = (f32x4){f[4], f[5], f[6], f[7]};
    *(f32x4*)(p + 512 + 8 * lane) = (f32x4){f[8], f[9], f[10], f[11]}; *(f32x4*)(p + 512 + 8 * lane + 4) = (f32x4){f[12], f[13], f[14], f[15]};
}
__device__ __forceinline__ void mixer_b_item(Ctx& F, int l, int seg) {
    unsigned char* const ws = kws();
    float* const out = kout();
    const int lane = opqv(F.lane);
    const int m0 = seg * 8;
    const bool samp = m0 >= MP;
    const int b = samp ? (m0 - MP) >> 3 : m0 >> 11, t0 = samp ? 0 : (m0 & (TP - 1));
    float w0[16], w1[16], w2[16], gb[16], p2[16], p1[16];
    load16f(karg(16) + (size_t)l * 3 * WB, lane, w0); load16f(karg(16) + (size_t)l * 3 * WB + WB, lane, w1); load16f(karg(16) + (size_t)l * 3 * WB + 2 * WB, lane, w2);
    load16f(karg(18) + (size_t)l * WB, lane, gb);
    if (samp) { const float* st = karg(2) + (size_t)(b * NL + l) * 2 * WB; load16f(st, lane, p2); load16f(st + WB, lane, p1); }
    else if (t0 == 0) {
#pragma unroll
        for (int j = 0; j < 16; ++j) { p2[j] = 0.f; p1[j] = 0.f; } }
    else { float a[16], c[16];
        load16b(((bf16*)(ws + WS_PROJ)) + (size_t)(m0 - 2) * INC + 3072, lane, a); load16b(((bf16*)(ws + WS_PROJ)) + (size_t)(m0 - 2) * INC + 4096, lane, c);
#pragma unroll
        for (int j = 0; j < 16; ++j) p2[j] = a[j] * c[j];
        load16b(((bf16*)(ws + WS_PROJ)) + (size_t)(m0 - 1) * INC + 3072, lane, a); load16b(((bf16*)(ws + WS_PROJ)) + (size_t)(m0 - 1) * INC + 4096, lane, c);
#pragma unroll
        for (int j = 0; j < 16; ++j) p1[j] = a[j] * c[j]; }
    const bool tail = samp || (t0 + 8 == TP);
    float* omix = (samp ? out + O_MIXS : out + O_MIXP) + (size_t)(b * NL + l) * 2 * WB;
#pragma unroll
    for (int r = 0; r < 8; ++r) {
        const bf16* pr = ((bf16*)(ws + WS_PROJ)) + (size_t)(m0 + r) * INC;
        float gbv[16], gc[16], hb[16], cin[16], ob[16];
        load16b(pr + 2048, lane, gbv); load16b(pr + 3072, lane, gc); load16b(pr + 4096, lane, hb);
        float ss = 0.f;
#pragma unroll
        for (int j = 0; j < 16; ++j) { cin[j] = gc[j] * hb[j]; ob[j] = gbv[j] * (w0[j] * p2[j] + w1[j] * p1[j] + w2[j] * cin[j]); ss += ob[j] * ob[j]; }
        const float rb = __builtin_amdgcn_rsqf(wave_sum(ss) * (1.0f / WB) + EPS);
        float oa[8], oc[8];
#pragma unroll
        for (int j = 0; j < 8; ++j) { oa[j] = ob[j] * rb * gb[j]; oc[j] = ob[8 + j] * rb * gb[8 + j]; }
        bf16* mr = ((bf16*)(ws + WS_MRG)) + (size_t)(m0 + r) * DM + WA;
        *(v4u*)(mr + 8 * lane) = pack8(oa); *(v4u*)(mr + 512 + 8 * lane) = pack8(oc);
        if (tail && r >= 6) store16f(omix + (size_t)(r - 6) * WB, lane, cin);
#pragma unroll
        for (int j = 0; j < 16; ++j) { p2[j] = p1[j]; p1[j] = cin[j]; }
    }
}
__device__ __forceinline__ void p2_mixer(Ctx& F, int l) {
    constexpr int NA = 144, NBB = (M / 8) / (2 * NWAVES);
    for (int u = F.bid; u < NA + NBB; u += F.G) {
        if (u < NA) { MA(mixer_a_unit(F, l, u)); }
        else { MB(mixer_b_item(F, l, ((u - NA) * NWAVES + F.wave) * 2); mixer_b_item(F, l, ((u - NA) * NWAVES + F.wave) * 2 + 1)); }
    }
}
__device__ __forceinline__ void conv_ffn_item(Ctx& F, int l, int item) {
    unsigned char* const ws = kws();
    float* const out = kout();
    const int lane = opqv(F.lane);
    const int seg = item / 11, cc = item - seg * 11;
    const bool samp = seg >= 512;
    const int b = samp ? seg - 512 : seg >> 7, t0 = samp ? 0 : (seg & 127) * 16, nrows = samp ? 8 : 16;
    const int m0 = samp ? MP + b * 8 : seg * 16;
    const int jg = cc * 512 + 8 * lane, jv = FF + jg;
    const float* wc = karg(21) + (size_t)l * 3 * FF2; const float* bc = karg(22) + (size_t)l * FF2;
    float w0g[8], w1g[8], w2g[8], bg[8], w0v[8], w1v[8], w2v[8], bv[8], g2[8], g1[8], v2[8], v1[8];
#define LD8F(dst, ptr) do { const f32x4 _a = *(const f32x4*)(ptr), _b = *(const f32x4*)((ptr) + 4); dst[0] = _a.x; dst[1] = _a.y; dst[2] = _a.z; dst[3] = _a.w; dst[4] = _b.x; dst[5] = _b.y; dst[6] = _b.z; dst[7] = _b.w; } while (0)
    LD8F(w0g, wc + jg); LD8F(w1g, wc + FF2 + jg); LD8F(w2g, wc + 2 * FF2 + jg); LD8F(bg, bc + jg);
    LD8F(w0v, wc + jv); LD8F(w1v, wc + FF2 + jv); LD8F(w2v, wc + 2 * FF2 + jv); LD8F(bv, bc + jv);
    if (samp) { const float* st = karg(3) + (size_t)(b * NL + l) * 2 * FF2; LD8F(g2, st + jg); LD8F(v2, st + jv); LD8F(g1, st + FF2 + jg); LD8F(v1, st + FF2 + jv); }
    else if (t0 == 0) {
#pragma unroll
        for (int j = 0; j < 8; ++j) { g2[j] = 0.f; g1[j] = 0.f; v2[j] = 0.f; v1[j] = 0.f; } }
    else { unpack8(*(const v4u*)(((bf16*)(ws + WS_UP)) + (size_t)(m0 - 2) * FF2 + jg), g2); unpack8(*(const v4u*)(((bf16*)(ws + WS_UP)) + (size_t)(m0 - 2) * FF2 + jv), v2);
           unpack8(*(const v4u*)(((bf16*)(ws + WS_UP)) + (size_t)(m0 - 1) * FF2 + jg), g1); unpack8(*(const v4u*)(((bf16*)(ws + WS_UP)) + (size_t)(m0 - 1) * FF2 + jv), v1); }
    const bool tail = samp || (t0 + 16 == TP);
    float* offn = (samp ? out + O_FFNS : out + O_FFNP) + (size_t)(b * NL + l) * 2 * FF2;
#pragma unroll 8
    for (int r = 0; r < nrows; ++r) {
        float xg[8], xv[8], a[8];
        unpack8(*(const v4u*)(((bf16*)(ws + WS_UP)) + (size_t)(m0 + r) * FF2 + jg), xg); unpack8(*(const v4u*)(((bf16*)(ws + WS_UP)) + (size_t)(m0 + r) * FF2 + jv), xv);
#pragma unroll
        for (int j = 0; j < 8; ++j) { const float G = w0g[j] * g2[j] + w1g[j] * g1[j] + w2g[j] * xg[j] + bg[j], V = w0v[j] * v2[j] + w1v[j] * v1[j] + w2v[j] * xv[j] + bv[j]; a[j] = silu_f(G) * V; }
        *(v4u*)(((bf16*)(ws + WS_ACT)) + (size_t)(m0 + r) * FF + jg) = pack8(a);
        if (tail && r >= nrows - 2) { float* o = offn + (size_t)(r - (nrows - 2)) * FF2;
            *(f32x4*)(o + jg) = (f32x4){xg[0], xg[1], xg[2], xg[3]}; *(f32x4*)(o + jg + 4) = (f32x4){xg[4], xg[5], xg[6], xg[7]};
            *(f32x4*)(o + jv) = (f32x4){xv[0], xv[1], xv[2], xv[3]}; *(f32x4*)(o + jv + 4) = (f32x4){xv[4], xv[5], xv[6], xv[7]}; }
#pragma unroll
        for (int j = 0; j < 8; ++j) { g2[j] = g1[j]; g1[j] = xg[j]; v2[j] = v1[j]; v1[j] = xv[j]; }
    }
#undef LD8F
}
__device__ __forceinline__ void p6_conv_ffn(Ctx& F, int l) {
    const int gw = F.bid * NWAVES + F.wave, NGW = F.G * NWAVES;
    constexpr int NITEMS = (512 + NS) * 11;
    for (int it = gw; it < NITEMS; it += NGW) conv_ffn_item(F, l, it);
}

__device__ __forceinline__ int opq(int v) { asm volatile("" : "+s"(v)); return v; }
struct Args { const float* in[24]; float* out; unsigned char* ws; int ph_lo, ph_hi; };
__global__ void __launch_bounds__(NTHREADS, 2) fwd(Args args) {
    extern __shared__ __attribute__((aligned(16))) unsigned char lds_raw[];
    Ctx F;
    F.lds = (LAS unsigned char*)lds_raw;
    volatile LAS unsigned* MISC = (volatile LAS unsigned*)(F.lds + MISC_OFF);
    F.tid = threadIdx.x; F.lane = F.tid & 63; F.wave = __builtin_amdgcn_readfirstlane(F.tid >> 6);
    F.G = gridDim.x; F.bid = blockIdx.x;
    gu32* ctl = (gu32*)(args.ws + WS_CTL);
    for (int u = F.tid; u < (LDS_BYTES - MISC_OFF) / 4; u += NTHREADS) ((LAS unsigned*)(F.lds + MISC_OFF))[u] = 0u;
    __syncthreads();
#if MK_PER_PHASE
#define SEAM(k) do { } while (0)
#else
    XcdBarrier bar = xcd_barrier_post((unsigned*)(ctl + CW_BAR), MISC + 8);
#define SEAM(k) do { if (lo <= (k) && (k) + 1 < hi) { for (int _r = 0; _r < REP_BAR; ++_r) xcd_barrier(bar); } } while (0)
#endif
    const int lo = args.ph_lo, hi = args.ph_hi;
#define IN(k) (lo <= (k) && (k) < hi)
    if (IN(0)) { T0(p0a_prologue(F)); }
    SEAM(0);
    if (IN(1)) {
        pg8::Gemm g{((bf16*)(kws() + WS_SC)), ((bf16*)(kws() + WS_WADA)), 256, NMODALL, DM}; pg8::StaticOrder S; S.init(256, NMODALL, DM, F.G, opq(F.bid));
        pg8::EpiF32 E{((float*)(kws() + WS_MOD)), NMODALL, karg(7), nullptr};
        GG0(pg8::gemm_phase<pg8::EpiF32, pg8::StaticOrder, true, true>(F.lds, g, S, E);)
    }
    SEAM(1);
    if (IN(2)) { T1(p0c_h0(F)); }
    SEAM(2);
#pragma unroll 1
    for (int l = 0; l < NL; ++l) {
        const int pb = 3 + 8 * l;
        if (IN(pb + 0)) {
            pg8::Gemm g{((bf16*)(kws() + WS_H)), ((bf16*)(kws() + WS_WIN)) + (size_t)l * INC * DM, M, INC, DM}; pg8::StaticOrder S; S.init(M, INC, DM, F.G, opq(F.bid));
            pg8::EpiBf16G E{((bf16*)(kws() + WS_PROJ)), INC, 8};
            GG1(pg8::gemm_phase<pg8::EpiBf16G, pg8::StaticOrder, true, true>(F.lds, g, S, E);)
        }
        SEAM(pb + 0);
        if (IN(pb + 1)) { T2(p2_mixer(F, l)); }
        SEAM(pb + 1);
        if (IN(pb + 2)) {
            pg8::Gemm g{((bf16*)(kws() + WS_MRG)), ((bf16*)(kws() + WS_WOUT)) + (size_t)l * DM * DM, M, DM, DM}; pg8::SplitOrder S; S.init(DM, F.G, opq(F.bid));
            pg8::EpiY E{((bf16*)(kws() + WS_YB)), ((float*)(kws() + WS_PART)), DM};
            GG2(pg8::gemm_phase<pg8::EpiY, pg8::SplitOrder, true, true>(F.lds, g, S, E);)
        }
        SEAM(pb + 2);
        if (IN(pb + 3)) { T3(row_update<true>(F, l)); }
        SEAM(pb + 3);
        if (IN(pb + 4)) {
            pg8::Gemm g{((bf16*)(kws() + WS_H)), ((bf16*)(kws() + WS_WUP)) + (size_t)l * FF2 * DM, M, FF2, DM}; pg8::StaticOrder S; S.init(M, FF2, DM, F.G, opq(F.bid));
            pg8::EpiBf16G E{((bf16*)(kws() + WS_UP)), FF2, 0};
            GG3(pg8::gemm_phase<pg8::EpiBf16G, pg8::StaticOrder, true, true>(F.lds, g, S, E);)
        }
        SEAM(pb + 4);
        if (IN(pb + 5)) { T4(p6_conv_ffn(F, l)); }
        SEAM(pb + 5);
        if (IN(pb + 6)) {
            pg8::Gemm g{((bf16*)(kws() + WS_ACT)), ((bf16*)(kws() + WS_WDN)) + (size_t)l * DM * FF, M, DM, FF}; pg8::SplitOrder S; S.init(FF, F.G, opq(F.bid));
            pg8::EpiY E{((bf16*)(kws() + WS_YB)), ((float*)(kws() + WS_PART)), DM};
            GG4(pg8::gemm_phase<pg8::EpiY, pg8::SplitOrder, true, true>(F.lds, g, S, E);)
        }
        SEAM(pb + 6);
        if (IN(pb + 7)) { T5(row_update<false>(F, l)); }
        SEAM(pb + 7);
    }
#undef IN
#undef SEAM
}

extern "C" void kernel_launch(void* const* d_in, const int* in_sizes, int n_in, void* d_out, int out_size, void* d_ws, size_t ws_size, hipStream_t stream) {
    static int grid = 0;
    if (grid == 0) {
        if (n_in != 24 || in_sizes[0] != MP * DM || (size_t)out_size != O_END || ws_size < WS_END) {
            fprintf(stderr, "kernel_launch: unexpected shapes (n_in %d, in0 %d, out %d, ws %zu); nothing launched\n", n_in, n_in > 0 ? in_sizes[0] : -1, out_size, ws_size); grid = -1; return; }
        int dev = 0, cus = 0, per_cu = 0;
        if (hipGetDevice(&dev) != hipSuccess || hipDeviceGetAttribute(&cus, hipDeviceAttributeMultiprocessorCount, dev) != hipSuccess) { grid = -1; return; }
        if (hipFuncSetAttribute((const void*)fwd, hipFuncAttributeMaxDynamicSharedMemorySize, LDS_BYTES) != hipSuccess) { fprintf(stderr, "kernel_launch: hipFuncSetAttribute failed\n"); grid = -1; return; }
        if (hipOccupancyMaxActiveBlocksPerMultiprocessor(&per_cu, (const void*)fwd, NTHREADS, LDS_BYTES) != hipSuccess || per_cu < 1) { fprintf(stderr, "kernel_launch: occupancy query says %d blocks per CU\n", per_cu); }
        (void)hipGetLastError();
        grid = cus;
    }
    if (grid < 0) return;
    if (hipMemsetAsync((char*)d_ws + WS_CTL, 0, CTL_ZERO_BYTES, stream) != hipSuccess) return;
    Args a{};
    for (int i = 0; i < 24; ++i) a.in[i] = (const float*)d_in[i];
    a.out = (float*)d_out; a.ws = (unsigned char*)d_ws;
#if MK_PER_PHASE
    for (int p = 0; p < NPHASES; ++p) { a.ph_lo = p; a.ph_hi = p + 1; hipLaunchKernelGGL(fwd, dim3(grid), dim3(NTHREADS), LDS_BYTES, stream, a); }
#else
    a.ph_lo = 0; a.ph_hi = NPHASES;
    hipLaunchKernelGGL(fwd, dim3(grid), dim3(NTHREADS), LDS_BYTES, stream, a);
#endif
    const hipError_t le = hipPeekAtLastError();
    if (le != hipSuccess) fprintf(stderr, "kernel_launch: launch failed: %s\n", hipGetErrorName(le));
}
```
